# Optimizing an MI355X kernel written in HIP

```python
import jax, jax.numpy as jnp
from jax import lax
import numpy as np

D_MODEL = 2048
BATCH = 4
SEQ = 2048
DEPTH = 2

N_MIXERS = 2
D_MIX = D_MODEL
F_GROUPS = 4
SGU_HEADS = 8
CHUNK = 128
N_GROUPS = 4
E_PER_GROUP = 8
N_EXPERTS = N_GROUPS * E_PER_GROUP
TOP_K = 2
D_EXPERT = D_MODEL // 4
EXPERT_BLOCK = 128
N_A = (DEPTH + 1) // 2
N_B = DEPTH // 2
EPS = 1e-6

kernel_name = "hybrid_fnet_sgu_hmoe_adaln_encoder"


def rms_norm(x, g):
    xf = x.astype(jnp.float32)
    y = xf * lax.rsqrt(jnp.mean(xf * xf, axis=-1, keepdims=True) + EPS)
    return (y * g.astype(jnp.float32)).astype(x.dtype)


def modulate(h, shift, scale):
    return h * (1 + scale[:, None, :]) + shift[:, None, :]


def fourier_mix(h, w_in, w_out):
    b, s, _ = h.shape
    z = (h @ w_in).reshape(b, s, F_GROUPS, D_MIX // F_GROUPS).astype(jnp.float32)
    f = jnp.fft.fft2(z, axes=(1, 3), norm="ortho").real
    return f.reshape(b, s, D_MIX).astype(h.dtype) @ w_out


def sgu_mix(h, w_in, b_in, g_v, w_s, b_s, w_out):
    b, s, _ = h.shape
    z = jax.nn.gelu(h @ w_in + b_in)
    u, v = jnp.split(z, 2, axis=-1)
    v = rms_norm(v, g_v)
    dh = D_MIX // SGU_HEADS
    vc = v.reshape(b, s // CHUNK, CHUNK, SGU_HEADS, dh)
    mixed = jnp.einsum('hpq,bcqhd->bcphd', w_s, vc) + b_s.T[None, None, :, :, None]
    gated = u.reshape(b, s // CHUNK, CHUNK, SGU_HEADS, dh) * mixed
    return gated.reshape(b, s, D_MIX) @ w_out


def hier_moe(h, w_group, b_group, w_router, b_router, w_gate, w_up, w_down):
    b, s, d = h.shape
    t = b * s
    xt = h.reshape(t, d)
    gl = (xt @ w_group).astype(jnp.float32) + b_group.astype(jnp.float32)
    gp = jax.nn.softmax(gl, axis=-1)
    g_idx = jnp.argmax(gl, axis=-1)
    g_w = jnp.take_along_axis(gp, g_idx[:, None], axis=-1)[:, 0]
    el = (xt @ w_router).astype(jnp.float32) + b_router.astype(jnp.float32)
    el = el.reshape(t, N_GROUPS, E_PER_GROUP)
    el_g = jnp.take_along_axis(el, g_idx[:, None, None], axis=1)[:, 0]
    top_v, top_i = lax.top_k(el_g, TOP_K)
    top_w = jax.nn.softmax(top_v, axis=-1) * g_w[:, None]
    expert_id = (g_idx[:, None] * E_PER_GROUP + top_i).astype(jnp.int32)

    n_assign = t * TOP_K
    e_flat = expert_id.reshape(n_assign)
    w_flat = top_w.reshape(n_assign)
    tok = jnp.repeat(jnp.arange(t, dtype=jnp.int32), TOP_K)
    order = jnp.argsort(e_flat)
    e_s, tok_s, w_s = e_flat[order], tok[order], w_flat[order]
    counts = jnp.zeros((N_EXPERTS,), jnp.int32).at[e_flat].add(1)
    starts = jnp.cumsum(counts) - counts
    padded = (counts + EXPERT_BLOCK - 1) // EXPERT_BLOCK * EXPERT_BLOCK
    pends = jnp.cumsum(padded)
    pstarts = pends - padded
    rank = jnp.arange(n_assign, dtype=jnp.int32) - starts[e_s]
    dest = pstarts[e_s] + rank
    n_blocks = (n_assign + N_EXPERTS * (EXPERT_BLOCK - 1) + EXPERT_BLOCK - 1) // EXPERT_BLOCK
    n_rows = n_blocks * EXPERT_BLOCK
    buf = jnp.zeros((n_rows, d), xt.dtype).at[dest].set(xt[tok_s])
    block_start = jnp.arange(n_blocks, dtype=jnp.int32) * EXPERT_BLOCK
    block_e = jnp.minimum(jnp.searchsorted(pends, block_start, side='right'), N_EXPERTS - 1)

    def expert_block(args):
        xb, e = args
        return (jax.nn.silu(xb @ w_gate[e]) * (xb @ w_up[e])) @ w_down[e]

    yb = lax.map(expert_block, (buf.reshape(n_blocks, EXPERT_BLOCK, d), block_e))
    y_s = yb.reshape(n_rows, d)[dest] * w_s[:, None].astype(xt.dtype)
    out = jnp.zeros((t, d), xt.dtype).at[tok_s].add(y_s)
    return out.reshape(b, s, d)


def setup_inputs(seed: int = 0) -> dict:
    key = jax.random.key(seed)
    ks = jax.random.split(key, 24)
    D, DM, DE, NE = D_MODEL, D_MIX, D_EXPERT, N_EXPERTS

    def nrm(k, shape, scale):
        return jax.random.normal(k, shape, jnp.float32) * scale

    return {
        "x": nrm(ks[0], (BATCH, SEQ, D), 1.0),
        "c": nrm(ks[1], (BATCH, D), 1.0),
        "g_norm1": 1.0 + nrm(ks[2], (DEPTH, D), 0.02),
        "g_norm2": 1.0 + nrm(ks[3], (DEPTH, D), 0.02),
        "w_ada": nrm(ks[4], (DEPTH, D, 6 * D), 0.5 * D ** -0.5),
        "b_ada": nrm(ks[5], (DEPTH, 6 * D), 0.02),
        "fa_w_in": nrm(ks[6], (N_A, D, DM), D ** -0.5),
        "fa_w_out": nrm(ks[7], (N_A, DM, D), DM ** -0.5),
        "sg_w_in": nrm(ks[8], (N_B, D, 2 * DM), D ** -0.5),
        "sg_b_in": nrm(ks[9], (N_B, 2 * DM), 0.02),
        "sg_g_v": 1.0 + nrm(ks[10], (N_B, DM), 0.02),
        "sg_w_s": nrm(ks[11], (N_B, SGU_HEADS, CHUNK, CHUNK), CHUNK ** -0.5),
        "sg_b_s": 1.0 + nrm(ks[12], (N_B, SGU_HEADS, CHUNK), 0.02),
        "sg_w_out": nrm(ks[13], (N_B, DM, D), DM ** -0.5),
        "w_group": nrm(ks[14], (DEPTH, D, N_GROUPS), D ** -0.5),
        "b_group": nrm(ks[15], (DEPTH, N_GROUPS), 0.01),
        "w_router": nrm(ks[16], (DEPTH, D, NE), D ** -0.5),
        "b_router": nrm(ks[17], (DEPTH, NE), 0.01),
        "w_gate": nrm(ks[18], (DEPTH, NE, D, DE), D ** -0.5),
        "w_up": nrm(ks[19], (DEPTH, NE, D, DE), D ** -0.5),
        "w_down": nrm(ks[20], (DEPTH, NE, DE, D), DE ** -0.5),
        "g_final": 1.0 + nrm(ks[21], (D,), 0.02),
    }


def reference(x, c, g_norm1, g_norm2, w_ada, b_ada, fa_w_in, fa_w_out,
              sg_w_in, sg_b_in, sg_g_v, sg_w_s, sg_b_s, sg_w_out,
              w_group, b_group, w_router, b_router, w_gate, w_up, w_down, g_final):
    c_act = jax.nn.silu(c)
    for l in range(DEPTH):
        mod = c_act @ w_ada[l] + b_ada[l]
        sh1, sc1, gt1, sh2, sc2, gt2 = jnp.split(mod, 6, axis=-1)
        h = modulate(rms_norm(x, g_norm1[l]), sh1, sc1)
        j = l // N_MIXERS
        if l % N_MIXERS == 0:
            y = fourier_mix(h, fa_w_in[j], fa_w_out[j])
        else:
            y = sgu_mix(h, sg_w_in[j], sg_b_in[j], sg_g_v[j], sg_w_s[j], sg_b_s[j], sg_w_out[j])
        x = x + gt1[:, None, :] * y
        h = modulate(rms_norm(x, g_norm2[l]), sh2, sc2)
        y = hier_moe(h, w_group[l], b_group[l], w_router[l], b_router[l],
                     w_gate[l], w_up[l], w_down[l])
        x = x + gt2[:, None, :] * y
    return rms_norm(x, g_final)
```

```cpp
#include <hip/hip_runtime.h>
#include <stdint.h>

namespace {
constexpr int D = 2048, NB = 4, S = 2048, T = NB * S;
constexpr int FG = 4, CG = 512;
constexpr int HEADS = 8, CH = 128, DH = 256;
constexpr int NG = 4, EPG = 8, NE = 32, DE = 512;
constexpr float EPS = 1e-6f;

__global__ void k_zero(int* p, int n) { int i = blockIdx.x * blockDim.x + threadIdx.x; if (i < n) p[i] = 0; }

__global__ void k_mod(const float* __restrict__ c, const float* __restrict__ w_ada, const float* __restrict__ b_ada, float* __restrict__ mod) {
    __shared__ float ca[NB][D];
    for (int i = threadIdx.x; i < NB * D; i += blockDim.x) { float v = c[i]; ca[i / D][i % D] = v / (1.f + __expf(-v)); }
    __syncthreads();
    const int l = blockIdx.y, j = blockIdx.x * blockDim.x + threadIdx.x;
    const float* w = w_ada + (size_t)l * D * 6 * D + j;
    float a0 = 0, a1 = 0, a2 = 0, a3 = 0;
    for (int k = 0; k < D; ++k) { float wv = w[(size_t)k * 6 * D]; a0 += ca[0][k] * wv; a1 += ca[1][k] * wv; a2 += ca[2][k] * wv; a3 += ca[3][k] * wv; }
    float bb = b_ada[l * 6 * D + j];
    float* m = mod + (size_t)l * NB * 6 * D + j;
    m[0] = a0 + bb; m[6 * D] = a1 + bb; m[2 * 6 * D] = a2 + bb; m[3 * 6 * D] = a3 + bb;
}

__global__ void k_resid_norm(const float* __restrict__ xin, const float* __restrict__ y0, const float* __restrict__ y1, const float* __restrict__ gate,
                             float* __restrict__ xout, const float* __restrict__ g, const float* __restrict__ shift, const float* __restrict__ scale,
                             float* __restrict__ hout) {
    const int t = blockIdx.x, b = t / S, tid = threadIdx.x;
    __shared__ float red[4];
    float v[8]; float ss = 0.f;
#pragma unroll
    for (int i = 0; i < 8; ++i) {
        const int d = tid + i * 256; float xv = xin[(size_t)t * D + d];
        if (y0) xv += gate[b * 6 * D + d] * (y0[(size_t)t * 2 * D + d] + y1[(size_t)t * 2 * D + d]);
        v[i] = xv; ss += xv * xv;
        if (xout) xout[(size_t)t * D + d] = xv;
    }
    for (int o = 32; o >= 1; o >>= 1) ss += __shfl_xor(ss, o);
    if ((tid & 63) == 0) red[tid >> 6] = ss;
    __syncthreads();
    ss = red[0] + red[1] + red[2] + red[3];
    const float rstd = rsqrtf(ss / D + EPS);
#pragma unroll
    for (int i = 0; i < 8; ++i) {
        const int d = tid + i * 256; float hv = v[i] * rstd * g[d];
        if (scale) hv = hv * (1.f + scale[b * 6 * D + d]) + shift[b * 6 * D + d];
        hout[(size_t)t * D + d] = hv;
    }
}

template <class AF, class BF>
__device__ __forceinline__ void tile_gemm(const AF& a, const BF& b, int K, int m0, int n0, float (&acc)[4][4]) {
    __shared__ float As[16][68], Bs[16][68];
    const int tid = threadIdx.x, tx = tid & 15, ty = tid >> 4;
#pragma unroll
    for (int i = 0; i < 4; ++i)
#pragma unroll
        for (int j = 0; j < 4; ++j) acc[i][j] = 0.f;
    for (int k0 = 0; k0 < K; k0 += 16) {
#pragma unroll
        for (int i = 0; i < 4; ++i) {
            const int e = tid + i * 256;
            { const int kk = e & 15, mm = e >> 4; As[kk][mm] = a(m0 + mm, k0 + kk); }
            { const int nn = e & 63, kk = e >> 6; Bs[kk][nn] = b(k0 + kk, n0 + nn); }
        }
        __syncthreads();
#pragma unroll
        for (int kk = 0; kk < 16; ++kk) {
            float av[4], bv[4];
#pragma unroll
            for (int i = 0; i < 4; ++i) av[i] = As[kk][ty * 4 + i];
#pragma unroll
            for (int j = 0; j < 4; ++j) bv[j] = Bs[kk][tx * 4 + j];
#pragma unroll
            for (int i = 0; i < 4; ++i)
#pragma unroll
                for (int j = 0; j < 4; ++j) acc[i][j] += av[i] * bv[j];
        }
        __syncthreads();
    }
}

__global__ void __launch_bounds__(256) k_gemm(const float* __restrict__ A, int lda, const float* __restrict__ B, int ldb, float* __restrict__ C, int ldc, int K, int kind,
                                             const float* __restrict__ base, const float* __restrict__ gate, const float* __restrict__ bias) {
    const int m0 = blockIdx.y * 64, n0 = blockIdx.x * 64;
    float acc[4][4];
    auto af = [&](int m, int k) { return A[(size_t)m * lda + k]; };
    auto bf = [&](int k, int n) { return B[(size_t)k * ldb + n]; };
    tile_gemm(af, bf, K, m0, n0, acc);
    const int tx = threadIdx.x & 15, ty = threadIdx.x >> 4;
#pragma unroll
    for (int i = 0; i < 4; ++i)
#pragma unroll
        for (int j = 0; j < 4; ++j) {
            const int m = m0 + ty * 4 + i, n = n0 + tx * 4 + j; float v = acc[i][j];
            if (kind == 1) { const int b = m / S; v = base[(size_t)m * ldc + n] + gate[b * 6 * D + n] * v; }
            if (kind == 2) { v += bias[n]; const float u = 0.7978845608028654f * (v + 0.044715f * v * v * v); v = 0.5f * v * (1.f + tanhf(u)); }
            C[(size_t)m * ldc + n] = v;
        }
}

__global__ void __launch_bounds__(256) k_chan_dft(const float* __restrict__ z, float* __restrict__ Tc, float* __restrict__ Ts) {
    const int g = blockIdx.z, m0 = blockIdx.y * 64, n0 = blockIdx.x * 64;
    float acc[4][4];
    auto af = [&](int m, int k) { return z[(size_t)m * D + g * CG + k]; };
    auto bf = [&](int k, int n) { const int k2 = n & (CG - 1); const int ph = (k2 * k) & (CG - 1); const float ang = (float)ph * (2.0f / CG);
                                  return n < CG ? cospif(ang) : sinpif(ang); };
    tile_gemm(af, bf, CG, m0, n0, acc);
    const int tx = threadIdx.x & 15, ty = threadIdx.x >> 4;
#pragma unroll
    for (int i = 0; i < 4; ++i)
#pragma unroll
        for (int j = 0; j < 4; ++j) {
            const int m = m0 + ty * 4 + i, n = n0 + tx * 4 + j;
            if (n < CG) Tc[(size_t)m * D + g * CG + n] = acc[i][j]; else Ts[(size_t)m * D + g * CG + (n - CG)] = acc[i][j];
        }
}

__global__ void __launch_bounds__(256) k_seq_dft(const float* __restrict__ Tc, const float* __restrict__ Ts, float* __restrict__ F) {
    const int b = blockIdx.z, m0 = blockIdx.y * 64, n0 = blockIdx.x * 64;
    float acc[4][4];
    auto af = [&](int m, int k) { const int n1 = k & (S - 1); const int ph = (m * n1) & (S - 1); const float ang = (float)ph * (2.0f / S);
                                  return k < S ? cospif(ang) : -sinpif(ang); };
    auto bf = [&](int k, int n) { return k < S ? Tc[((size_t)b * S + k) * D + n] : Ts[((size_t)b * S + (k - S)) * D + n]; };
    tile_gemm(af, bf, 2 * S, m0, n0, acc);
    const int tx = threadIdx.x & 15, ty = threadIdx.x >> 4;
#pragma unroll
    for (int i = 0; i < 4; ++i)
#pragma unroll
        for (int j = 0; j < 4; ++j) F[((size_t)b * S + m0 + ty * 4 + i) * D + n0 + tx * 4 + j] = acc[i][j] * (1.0f / 1024.0f);
}

__global__ void k_route(const float* __restrict__ h, const float* __restrict__ w_group, const float* __restrict__ b_group,
                        const float* __restrict__ w_router, const float* __restrict__ b_router,
                        int* __restrict__ counts, int* __restrict__ lists, float* __restrict__ tok_w) {
    const int t = blockIdx.x, tid = threadIdx.x;
    __shared__ float hs[D]; __shared__ float lg[36];
    for (int i = tid; i < D; i += 64) hs[i] = h[(size_t)t * D + i];
    __syncthreads();
    if (tid < 36) {
        float a = 0.f;
        if (tid < 4) { for (int k = 0; k < D; ++k) a += hs[k] * w_group[k * NG + tid]; a += b_group[tid]; }
        else { const int e = tid - 4; for (int k = 0; k < D; ++k) a += hs[k] * w_router[k * NE + e]; a += b_router[e]; }
        lg[tid] = a;
    }
    __syncthreads();
    if (tid == 0) {
        int gi = 0; float gm = lg[0];
        for (int i = 1; i < NG; ++i) if (lg[i] > gm) { gm = lg[i]; gi = i; }
        float se = 0.f; for (int i = 0; i < NG; ++i) se += __expf(lg[i] - gm);
        const float gw = 1.f / se;
        const float* el = lg + 4 + gi * EPG;
        int i0 = 0; float v0 = el[0];
        for (int i = 1; i < EPG; ++i) if (el[i] > v0) { v0 = el[i]; i0 = i; }
        int i1 = -1; float v1 = -3.4e38f;
        for (int i = 0; i < EPG; ++i) if (i != i0 && el[i] > v1) { v1 = el[i]; i1 = i; }
        const float e1 = __expf(v1 - v0); const float p0 = 1.f / (1.f + e1), p1 = e1 / (1.f + e1);
        const int ex0 = gi * EPG + i0, ex1 = gi * EPG + i1;
        tok_w[t * 2 + 0] = p0 * gw; tok_w[t * 2 + 1] = p1 * gw;
        const int q0 = atomicAdd(&counts[ex0], 1); lists[ex0 * T + q0] = t * 2 + 0;
        const int q1 = atomicAdd(&counts[ex1], 1); lists[ex1 * T + q1] = t * 2 + 1;
    }
}

__global__ void __launch_bounds__(256) k_moe1(const float* __restrict__ h, const float* __restrict__ w_gate, const float* __restrict__ w_up,
                                             const int* __restrict__ counts, const int* __restrict__ lists, float* __restrict__ act) {
    const int e = blockIdx.z, m0 = blockIdx.y * 64, n0 = blockIdx.x * 64;
    const int cnt = counts[e]; if (m0 >= cnt) return;
    int base = 0; for (int i = 0; i < e; ++i) base += counts[i];
    const int* lst = lists + (size_t)e * T;
    float ag[4][4], au[4][4];
    auto af = [&](int m, int k) { return m < cnt ? h[(size_t)(lst[m] >> 1) * D + k] : 0.f; };
    { const float* W = w_gate + (size_t)e * D * DE; auto bf = [&](int k, int n) { return W[(size_t)k * DE + n]; }; tile_gemm(af, bf, D, m0, n0, ag); }
    { const float* W = w_up + (size_t)e * D * DE; auto bf = [&](int k, int n) { return W[(size_t)k * DE + n]; }; tile_gemm(af, bf, D, m0, n0, au); }
    const int tx = threadIdx.x & 15, ty = threadIdx.x >> 4;
#pragma unroll
    for (int i = 0; i < 4; ++i)
#pragma unroll
        for (int j = 0; j < 4; ++j) { const int m = m0 + ty * 4 + i, n = n0 + tx * 4 + j;
            if (m < cnt) { const float gv = ag[i][j]; act[(size_t)(base + m) * DE + n] = gv / (1.f + __expf(-gv)) * au[i][j]; } }
}
__global__ void __launch_bounds__(256) k_moe2(const float* __restrict__ act, const float* __restrict__ w_down, const int* __restrict__ counts, const int* __restrict__ lists,
                                             const float* __restrict__ tok_w, float* __restrict__ ybuf) {
    const int e = blockIdx.z, m0 = blockIdx.y * 64, n0 = blockIdx.x * 64;
    const int cnt = counts[e]; if (m0 >= cnt) return;
    int base = 0; for (int i = 0; i < e; ++i) base += counts[i];
    const int* lst = lists + (size_t)e * T;
    float acc[4][4];
    auto af = [&](int m, int k) { return m < cnt ? act[(size_t)(base + m) * DE + k] : 0.f; };
    const float* W = w_down + (size_t)e * DE * D; auto bf = [&](int k, int n) { return W[(size_t)k * D + n]; };
    tile_gemm(af, bf, DE, m0, n0, acc);
    const int tx = threadIdx.x & 15, ty = threadIdx.x >> 4;
#pragma unroll
    for (int i = 0; i < 4; ++i) { const int m = m0 + ty * 4 + i; if (m < cnt) { const int ent = lst[m]; const float w = tok_w[ent];
#pragma unroll
        for (int j = 0; j < 4; ++j) ybuf[(size_t)ent * D + n0 + tx * 4 + j] = w * acc[i][j]; } }
}

__global__ void k_vnorm(float* __restrict__ zb, const float* __restrict__ g_v) {
    const int t = blockIdx.x, tid = threadIdx.x; __shared__ float red[4];
    float v[8]; float ss = 0.f;
#pragma unroll
    for (int i = 0; i < 8; ++i) { v[i] = zb[(size_t)t * 2 * D + D + tid + i * 256]; ss += v[i] * v[i]; }
    for (int o = 32; o >= 1; o >>= 1) ss += __shfl_xor(ss, o);
    if ((tid & 63) == 0) red[tid >> 6] = ss;
    __syncthreads();
    ss = red[0] + red[1] + red[2] + red[3];
    const float rstd = rsqrtf(ss / D + EPS);
#pragma unroll
    for (int i = 0; i < 8; ++i) zb[(size_t)t * 2 * D + D + tid + i * 256] = v[i] * rstd * g_v[tid + i * 256];
}
__global__ void __launch_bounds__(256) k_sgu_mix(const float* __restrict__ zb, const float* __restrict__ w_s, const float* __restrict__ b_s, float* __restrict__ gated) {
    const int ch = blockIdx.z >> 3, hd = blockIdx.z & 7, m0 = blockIdx.y * 64, n0 = blockIdx.x * 64;
    float acc[4][4];
    auto af = [&](int m, int k) { return w_s[((size_t)hd * CH + m) * CH + k]; };
    auto bf = [&](int k, int n) { return zb[(size_t)(ch * CH + k) * 2 * D + D + hd * DH + n]; };
    tile_gemm(af, bf, CH, m0, n0, acc);
    const int tx = threadIdx.x & 15, ty = threadIdx.x >> 4;
#pragma unroll
    for (int i = 0; i < 4; ++i)
#pragma unroll
        for (int j = 0; j < 4; ++j) { const int p = m0 + ty * 4 + i, d = n0 + tx * 4 + j; const size_t tok = (size_t)ch * CH + p;
            gated[tok * D + hd * DH + d] = zb[tok * 2 * D + hd * DH + d] * (acc[i][j] + b_s[hd * CH + p]); }
}
}

extern "C" void kernel_launch(void* const* d_in, const int* in_sizes, int n_in, void* d_out, int out_size, void* d_ws, size_t ws_size, hipStream_t stream) {
    const float* x = (const float*)d_in[0];      const float* c = (const float*)d_in[1];
    const float* g_norm1 = (const float*)d_in[2]; const float* g_norm2 = (const float*)d_in[3];
    const float* w_ada = (const float*)d_in[4];  const float* b_ada = (const float*)d_in[5];
    const float* fa_w_in = (const float*)d_in[6]; const float* fa_w_out = (const float*)d_in[7];
    const float* sg_w_in = (const float*)d_in[8]; const float* sg_b_in = (const float*)d_in[9];
    const float* sg_g_v = (const float*)d_in[10]; const float* sg_w_s = (const float*)d_in[11];
    const float* sg_b_s = (const float*)d_in[12]; const float* sg_w_out = (const float*)d_in[13];
    const float* w_group = (const float*)d_in[14]; const float* b_group = (const float*)d_in[15];
    const float* w_router = (const float*)d_in[16]; const float* b_router = (const float*)d_in[17];
    const float* w_gate = (const float*)d_in[18]; const float* w_up = (const float*)d_in[19];
    const float* w_down = (const float*)d_in[20]; const float* g_final = (const float*)d_in[21];
    float* out = (float*)d_out;

    float* ws = (float*)d_ws; size_t off = 0;
    auto take = [&](size_t n) { float* p = ws + off; off += (n + 63) & ~(size_t)63; return p; };
    const size_t TD = (size_t)T * D;
    float* mod = take((size_t)2 * NB * 6 * D);
    float* hbuf = take(TD);
    float* b1 = take(2 * TD);
    float* b2 = take(2 * TD);
    float* fbuf = take(TD);
    float* xa = take(TD);
    float* xb = take(TD);
    float* act = take((size_t)2 * T * DE);
    float* tok_w = take((size_t)2 * T);
    int* counts = (int*)take(64);
    int* lists = (int*)take((size_t)NE * T);

    k_mod<<<dim3(6 * D / 256, 2), 256, 0, stream>>>(c, w_ada, b_ada, mod);
    const float* xcur = x;
    for (int l = 0; l < 2; ++l) {
        const float* m = mod + (size_t)l * NB * 6 * D;
        const float *sh1 = m, *sc1 = m + D, *gt1 = m + 2 * D, *sh2 = m + 3 * D, *sc2 = m + 4 * D, *gt2 = m + 5 * D;
        if (l == 0) k_resid_norm<<<T, 256, 0, stream>>>(xcur, nullptr, nullptr, nullptr, nullptr, g_norm1 + l * D, sh1, sc1, hbuf);
        else { const float* pm = mod; k_resid_norm<<<T, 256, 0, stream>>>(xa, b2, b2 + D, pm + 5 * D, xb, g_norm1 + l * D, sh1, sc1, hbuf); xcur = xb; }
        if (l == 0) {
            k_gemm<<<dim3(D / 64, T / 64), 256, 0, stream>>>(hbuf, D, fa_w_in, D, b1, D, D, 0, nullptr, nullptr, nullptr);
            k_chan_dft<<<dim3(2 * CG / 64, T / 64, FG), 256, 0, stream>>>(b1, b2, b2 + TD);
            k_seq_dft<<<dim3(D / 64, S / 64, NB), 256, 0, stream>>>(b2, b2 + TD, fbuf);
            k_gemm<<<dim3(D / 64, T / 64), 256, 0, stream>>>(fbuf, D, fa_w_out, D, xa, D, D, 1, xcur, gt1, nullptr);
        } else {
            k_gemm<<<dim3(2 * D / 64, T / 64), 256, 0, stream>>>(hbuf, D, sg_w_in, 2 * D, b1, 2 * D, D, 2, nullptr, nullptr, sg_b_in);
            k_vnorm<<<T, 256, 0, stream>>>(b1, sg_g_v);
            k_sgu_mix<<<dim3(DH / 64, CH / 64, (T / CH) * HEADS), 256, 0, stream>>>(b1, sg_w_s, sg_b_s, fbuf);
            k_gemm<<<dim3(D / 64, T / 64), 256, 0, stream>>>(fbuf, D, sg_w_out, D, xa, D, D, 1, xcur, gt1, nullptr);
        }
        k_resid_norm<<<T, 256, 0, stream>>>(xa, nullptr, nullptr, nullptr, nullptr, g_norm2 + l * D, sh2, sc2, hbuf);
        k_zero<<<1, 64, 0, stream>>>(counts, 64);
        k_route<<<T, 64, 0, stream>>>(hbuf, w_group + (size_t)l * D * NG, b_group + l * NG, w_router + (size_t)l * D * NE, b_router + l * NE, counts, lists, tok_w);
        k_moe1<<<dim3(DE / 64, T / 64, NE), 256, 0, stream>>>(hbuf, w_gate + (size_t)l * NE * D * DE, w_up + (size_t)l * NE * D * DE, counts, lists, act);
        k_moe2<<<dim3(D / 64, T / 64, NE), 256, 0, stream>>>(act, w_down + (size_t)l * NE * DE * D, counts, lists, tok_w, b2);
        (void)gt2;
    }
    k_resid_norm<<<T, 256, 0, stream>>>(xa, b2, b2 + D, mod + (size_t)NB * 6 * D + 5 * D, nullptr, g_final, nullptr, nullptr, out);
}
```

```cpp
#include <hip/hip_runtime.h>
#include <stdint.h>
#include <cstdio>

#ifndef MK_MULTI
#define MK_MULTI 0
#endif

namespace mk {
#define LAS __attribute__((address_space(3)))
typedef unsigned short bf16_t;
typedef short bf16x8 __attribute__((ext_vector_type(8)));
typedef short s16x4 __attribute__((ext_vector_type(4)));
typedef float f32x4 __attribute__((ext_vector_type(4)));
typedef float f32x2 __attribute__((ext_vector_type(2)));
typedef unsigned u32x2 __attribute__((ext_vector_type(2)));
typedef unsigned u32x4 __attribute__((ext_vector_type(4)));

constexpr int D = 2048, NB = 4, S = 2048, T = NB * S;
constexpr int CG = 512;
constexpr int HEADS = 8, CH = 128, DH = 256;
constexpr int NG = 4, EPG = 8, NE = 32, DE = 512;
constexpr float EPS = 1e-6f;
constexpr int NPH = 17;

constexpr size_t MiB = 1u << 20;
constexpr size_t WS_CTL = 0, CTL_BYTES = 1 * MiB;
constexpr size_t WS_MOD = 1 * MiB;
constexpr size_t WS_WFIN = 2 * MiB;
constexpr size_t WS_WFOUT = 10 * MiB;
constexpr size_t WS_WSGIN = 18 * MiB;
constexpr size_t WS_WSGOUT = 34 * MiB;
constexpr size_t WS_DFTC = 42 * MiB;
constexpr size_t WS_DFTS = 44 * MiB;
constexpr size_t WS_HA = 60 * MiB;
constexpr size_t WS_ZB = 92 * MiB;
constexpr size_t WS_T2 = 124 * MiB;
constexpr size_t WS_FB = 188 * MiB;
constexpr size_t WS_XA = 220 * MiB;
constexpr size_t WS_XB = 284 * MiB;
constexpr size_t WS_ACT = 348 * MiB;
constexpr size_t WS_YB = 366 * MiB;
constexpr size_t WS_VSS = 430 * MiB;
constexpr size_t WS_LISTS = 432 * MiB;
constexpr size_t WS_TOKW = 435 * MiB;
constexpr size_t WS_END = 436 * MiB;
constexpr int CW_COUNTS = 64;
constexpr int CW_BAR = 4096;

constexpr int HTB = 16384;
constexpr int RING_BYTES = 131072;
constexpr int MISC_OFF = RING_BYTES;
constexpr int LDS_BYTES = 147456;
#define SA_OFF(b, h) (((b) * 2 + (h)) * HTB)
#define SB_OFF(b, h) ((4 + (b) * 2 + (h)) * HTB)

#define XB_TMO      128
#define XB_XCNT(j)  (256  + 64 * (j))
#define XB_XSUB(j)  (1280 + 64 * (j))
#define XB_XGEN(j)  (2304 + 64 * (j))
#define XB_TOP      3328
#define XB_TOPGEN   3392
#define XCD_BAR_WORDS 3456
#define XB_SPIN_CAP (1u << 18)
__device__ __forceinline__ unsigned xb_ld(unsigned* p)              { return __hip_atomic_load(p, __ATOMIC_RELAXED, __HIP_MEMORY_SCOPE_AGENT); }
__device__ __forceinline__ unsigned xb_add(unsigned* p, unsigned v) { return __hip_atomic_fetch_add(p, v, __ATOMIC_RELAXED, __HIP_MEMORY_SCOPE_AGENT); }
__device__ __forceinline__ unsigned xb_xcc_id() { return (unsigned)__builtin_amdgcn_s_getreg((3 << 11) | 20) & 0xFu; }
#define XB_SPIN(cond, bar) do { unsigned _sp = 0; while (cond) { __builtin_amdgcn_s_sleep(1); \
    if ((++_sp & 255u) == 0u) { if (xb_ld(&(bar)[XB_TMO])) break; if (_sp > XB_SPIN_CAP) { atomicAdd(&(bar)[XB_TMO], 1u); break; } } } } while (0)
struct XcdBarrier { unsigned* bar; unsigned x; volatile LAS unsigned* st; };
__device__ __forceinline__ XcdBarrier xcd_barrier_post(unsigned* bar, volatile LAS unsigned* st, int tid) {
    XcdBarrier b; b.bar = bar; b.x = xb_xcc_id(); b.st = st;
    if (tid == 0) (void)xb_add(&bar[XB_XCNT(b.x)], 1u);
    return b;
}
__device__ __forceinline__ void xcd_barrier_complete(unsigned* bar, unsigned x, unsigned& nloc, unsigned& nx) {
    const unsigned G = gridDim.x * gridDim.y * gridDim.z;
    unsigned sum, cnt, mine, sp = 0u;
    for (;;) {
        sum = 0u; cnt = 0u; mine = 0u;
#pragma unroll
        for (unsigned j = 0; j < 16; ++j) { const unsigned c = xb_ld(&bar[XB_XCNT(j)]); sum += c; cnt += (c > 0u) ? 1u : 0u; mine = (j == x) ? c : mine; }
        if (sum == G) break;
        __builtin_amdgcn_s_sleep(1);
        if ((++sp & 255u) == 0u) { if (xb_ld(&bar[XB_TMO])) break; if (sp > XB_SPIN_CAP) { atomicAdd(&bar[XB_TMO], 1u); break; } }
    }
    nloc = mine > 0u ? mine : 1u; nx = cnt > 0u ? cnt : 1u;
}
__device__ __forceinline__ void xcd_barrier(const XcdBarrier& b, int tid) {
    asm volatile("s_waitcnt vmcnt(0)" ::: "memory");
    __syncthreads();
    if (tid == 0) {
        unsigned* bar = b.bar;
        __builtin_amdgcn_s_waitcnt(0);
        unsigned nloc = b.st[0], nx = b.st[1];
        if (nloc == 0u) { xcd_barrier_complete(bar, b.x, nloc, nx); b.st[0] = nloc; b.st[1] = nx; }
        const unsigned old = xb_add(&bar[XB_XSUB(b.x)], 1u);
        const unsigned gen = old / nloc;
        if (old + 1u == (gen + 1u) * nloc) {
            __builtin_amdgcn_fence(__ATOMIC_RELEASE, "agent");
            asm volatile("s_waitcnt vmcnt(0)" ::: "memory");
            const unsigned og = xb_add(&bar[XB_TOP], 1u);
            const unsigned tg = og / nx;
            if (og + 1u == (tg + 1u) * nx) xb_add(&bar[XB_TOPGEN], 1u);
            else XB_SPIN(xb_ld(&bar[XB_TOPGEN]) == tg, bar);
            __builtin_amdgcn_fence(__ATOMIC_ACQUIRE, "agent");
            xb_add(&bar[XB_XGEN(b.x)], 1u);
            asm volatile("s_waitcnt vmcnt(0)" ::: "memory");
        } else {
            XB_SPIN(xb_ld(&bar[XB_XGEN(b.x)]) == gen, bar);
            __builtin_amdgcn_fence(__ATOMIC_ACQUIRE, "agent");
            asm volatile("s_waitcnt vmcnt(0)" ::: "memory");
        }
    }
    __syncthreads();
}

__device__ __forceinline__ unsigned cvt_pk(float lo, float hi) { unsigned r; asm("v_cvt_pk_bf16_f32 %0, %1, %2" : "=v"(r) : "v"(lo), "v"(hi)); return r; }
__device__ __forceinline__ float bf_lo(unsigned w) { return __uint_as_float(w << 16); }
__device__ __forceinline__ float bf_hi(unsigned w) { return __uint_as_float(w & 0xffff0000u); }
__device__ __forceinline__ float wave_sum(float v) {
#pragma unroll
    for (int o = 1; o < 64; o <<= 1) v += __shfl_xor(v, o);
    return v;
}
__device__ __forceinline__ int opaque_lane() { int l = (int)__builtin_amdgcn_mbcnt_hi(~0u, __builtin_amdgcn_mbcnt_lo(~0u, 0u)); asm volatile("" : "+v"(l)); return l; }
#define WAIT_V(n) asm volatile("s_waitcnt vmcnt(" #n ")" ::: "memory")
#define WAIT_L0() asm volatile("s_waitcnt lgkmcnt(0)" ::: "memory")
#define BAR() __builtin_amdgcn_s_barrier()

__device__ __forceinline__ int lds_byte(int r, int c) { const int st = (r >> 4) * 2 + (c >> 5), rr = r & 15, cc = c & 31, ob = rr * 64 + cc * 2; return st * 1024 + (ob ^ (((ob >> 9) & 1) << 5)); }
__device__ __forceinline__ void stage_rc(int b, int& R, int& C) { const int st = b / 1024, sb = b % 1024, swz = sb ^ (((sb >> 9) & 1) << 5); R = (st >> 1) * 16 + swz / 64; C = (st & 1) * 32 + (swz % 64) / 2; }
__device__ __forceinline__ int brow_f(int row) { return (row & 3) | (((row >> 3) & 1) << 2); }

struct GemmLane {
    int wid, lane, wr, wc, fr, fq;
    int Ra[2], Ca[2];
    unsigned aoff;
    unsigned boff[2];
    int Rb[2], Cb16[2];
};
__device__ __forceinline__ GemmLane make_lane(int tid) {
    GemmLane L;
    L.wid = __builtin_amdgcn_readfirstlane(tid >> 6); L.lane = tid & 63; L.wr = L.wid >> 2; L.wc = L.wid & 3; L.fr = L.lane & 15; L.fq = L.lane >> 4;
#pragma unroll
    for (int i = 0; i < 2; ++i) {
        stage_rc(tid * 16 + i * 8192, L.Ra[i], L.Ca[i]);
        const int row = i * 32 + (tid >> 4); const int slot_phys = (tid & 15) >> 1; const int slot_log = slot_phys ^ brow_f(row);
        L.Rb[i] = row; L.Cb16[i] = slot_log * 2 + (tid & 1);
    }
    L.aoff = (unsigned)lds_byte(L.wr * 64 + L.fr, L.fq * 8);
    const int q = (L.lane & 15) >> 2, p = L.lane & 3, f = q | ((L.fq & 1) << 2);
#pragma unroll
    for (int n = 0; n < 2; ++n) L.boff[n] = (unsigned)((8 * L.fq + q) * 256 + 8 * p + (((L.wc * 2 + n) ^ f) * 32));
    return L;
}

template <int BMODE, int NAI>
__device__ __forceinline__ void gemm_unit(LAS unsigned char* lds, const GemmLane& L, const char* Ab, const unsigned (&voffA)[2][2],
                                          const char* B0, const char* B1, unsigned ldb_bytes, int nt, f32x4 (&acc)[2][2][4][2]) {
    const int wid = L.wid, lane = L.lane;
    asm volatile("" : "+s"(nt));
#pragma unroll
    for (int a = 0; a < 2; ++a)
#pragma unroll
        for (int b = 0; b < 2; ++b)
#pragma unroll
            for (int m = 0; m < 4; ++m)
#pragma unroll
                for (int n = 0; n < 2; ++n) acc[a][b][m][n] = (f32x4){0.f, 0.f, 0.f, 0.f};
    bf16x8 At[4][2], Bf0[2][2], Bf1[2][2];
    unsigned voffB[2];
    if (BMODE == 0) {
#pragma unroll
        for (int i = 0; i < 2; ++i) voffB[i] = (unsigned)L.Rb[i] * ldb_bytes + (unsigned)L.Cb16[i] * 16u;
    }
    const char* bp = nullptr; unsigned bw_base = 0;
    if (BMODE == 1) { bp = ((lane >> 5) ? B1 : B0) + (lane & 31) * 16; bw_base = (unsigned)((lane >> 5) * HTB + (wid * 8) * 256 + (lane & 3) * 8); }
    f32x4 X[4], Y[4];

#define G_STAGE_A(buf, kt) do { _Pragma("unroll") for (int _h = 0; _h < NAI; ++_h) _Pragma("unroll") for (int _i = 0; _i < 2; ++_i) \
        __builtin_amdgcn_global_load_lds((const unsigned*)(Ab + (size_t)(kt) * 128 + voffA[_h][_i]), (LAS unsigned*)(lds + SA_OFF(buf, _h) + wid * 1024 + _i * 8192), 16, 0, 0); } while (0)
#define G_STAGE_B(buf, kt) do { const char* _bb = B0 + (size_t)(kt) * 64 * ldb_bytes; _Pragma("unroll") for (int _h = 0; _h < 2; ++_h) _Pragma("unroll") for (int _i = 0; _i < 2; ++_i) \
        __builtin_amdgcn_global_load_lds((const unsigned*)(_bb + _h * 256 + voffB[_i]), (LAS unsigned*)(lds + SB_OFF(buf, _h) + wid * 1024 + _i * 8192), 16, 0, 0); } while (0)
#define G_LOADX(V, j0, kt) do { _Pragma("unroll") for (int _j = 0; _j < 4; ++_j) V[_j] = *(const f32x4*)(bp + (size_t)((kt) * 64 + wid * 8 + (j0) + _j) * ldb_bytes); } while (0)
#define G_WRITEX(V, j0, buf) do { _Pragma("unroll") for (int _j = 0; _j < 4; ++_j) { const int _jj = (j0) + _j; const int _f = (_jj & 3) | ((wid & 1) << 2); \
        u32x2 _w; _w.x = cvt_pk(V[_j][0], V[_j][1]); _w.y = cvt_pk(V[_j][2], V[_j][3]); \
        *(LAS u32x2*)(lds + SB_OFF(buf, 0) + bw_base + _jj * 256 + ((((lane & 31) >> 2) ^ _f) * 32)) = _w; } } while (0)
#define G_LDA(buf, h) do { _Pragma("unroll") for (int _m = 0; _m < 4; ++_m) _Pragma("unroll") for (int _k = 0; _k < 2; ++_k) \
        At[_m][_k] = *(const LAS bf16x8*)(lds + SA_OFF(buf, h) + L.aoff + _m * 2048 + _k * 1024); } while (0)
#define G_LDB(dst, buf, h) do { _Pragma("unroll") for (int _n = 0; _n < 2; ++_n) _Pragma("unroll") for (int _k = 0; _k < 2; ++_k) { \
        const s16x4 _lo = __builtin_amdgcn_ds_read_tr16_b64_v4i16((LAS s16x4*)(lds + SB_OFF(buf, h) + L.boff[_n] + _k * 8192)); \
        const s16x4 _hi = __builtin_amdgcn_ds_read_tr16_b64_v4i16((LAS s16x4*)(lds + SB_OFF(buf, h) + L.boff[_n] + _k * 8192 + 1024)); \
        dst[_n][_k] = __builtin_shufflevector(_lo, _hi, 0, 1, 2, 3, 4, 5, 6, 7); } } while (0)
#define G_MMA(ai, bj, Bt) do { _Pragma("unroll") for (int _m = 0; _m < 4; ++_m) _Pragma("unroll") for (int _n = 0; _n < 2; ++_n) _Pragma("unroll") for (int _k = 0; _k < 2; ++_k) \
        acc[ai][bj][_m][_n] = __builtin_amdgcn_mfma_f32_16x16x32_bf16(Bt[_n][_k], At[_m][_k], acc[ai][bj][_m][_n], 0, 0, 0); } while (0)

    WAIT_V(0); WAIT_L0(); BAR();
    if (BMODE == 0) {
        G_STAGE_A(0, 0); G_STAGE_B(0, 0);
#define G_ITER0(p, t) do { WAIT_V(0); BAR(); \
            if ((t) + 1 < nt) { G_STAGE_A(1 - (p), (t) + 1); G_STAGE_B(1 - (p), (t) + 1); } \
            G_LDB(Bf0, p, 0); G_LDA(p, 0); G_MMA(0, 0, Bf0); G_LDB(Bf1, p, 1); G_MMA(0, 1, Bf1); \
            if (NAI == 2) { G_LDA(p, 1); G_MMA(1, 0, Bf0); G_MMA(1, 1, Bf1); } } while (0)
        for (int t = 0; t < nt; t += 2) { G_ITER0(0, t); G_ITER0(1, t + 1); }
#undef G_ITER0
    } else {
        G_LOADX(X, 0, 0); G_LOADX(Y, 4, 0); G_STAGE_A(0, 0);
        WAIT_V(0);
        G_WRITEX(X, 0, 0); G_WRITEX(Y, 4, 0);
        if (nt > 1) { G_LOADX(X, 0, 1); G_LOADX(Y, 4, 1); }
#define G_LDA2(buf, h, mh) do { _Pragma("unroll") for (int _m = 0; _m < 2; ++_m) _Pragma("unroll") for (int _k = 0; _k < 2; ++_k) \
        At[_m][_k] = *(const LAS bf16x8*)(lds + SA_OFF(buf, h) + L.aoff + ((mh) * 2 + _m) * 2048 + _k * 1024); } while (0)
#define G_MMA2(ai, bj, mh) do { _Pragma("unroll") for (int _m = 0; _m < 2; ++_m) _Pragma("unroll") for (int _n = 0; _n < 2; ++_n) _Pragma("unroll") for (int _k = 0; _k < 2; ++_k) \
        acc[ai][bj][(mh) * 2 + _m][_n] = __builtin_amdgcn_mfma_f32_16x16x32_bf16(Bf0[_n][_k], At[_m][_k], acc[ai][bj][(mh) * 2 + _m][_n], 0, 0, 0); } while (0)
#define G_BLK(p, ai, bj) do { G_LDA2(p, ai, 0); G_MMA2(ai, bj, 0); G_LDA2(p, ai, 1); G_MMA2(ai, bj, 1); } while (0)
#define G_ITER1(p, t) do { const bool _n1 = ((t) + 1 < nt), _n2 = ((t) + 2 < nt); \
            if (_n1) { WAIT_V(8); } else { WAIT_V(0); } WAIT_L0(); BAR(); \
            if (_n1) { G_STAGE_A(1 - (p), (t) + 1); } \
            G_LDB(Bf0, p, 0); G_BLK(p, 0, 0); if (NAI == 2) { G_BLK(p, 1, 0); } \
            if (_n1) { WAIT_V(8); G_WRITEX(X, 0, 1 - (p)); if (_n2) { G_LOADX(X, 0, (t) + 2); } } \
            G_LDB(Bf0, p, 1); G_BLK(p, 0, 1); \
            if (_n1) { if (_n2) { WAIT_V(8); } else { WAIT_V(4); } G_WRITEX(Y, 4, 1 - (p)); if (_n2) { G_LOADX(Y, 4, (t) + 2); } } \
            if (NAI == 2) { G_BLK(p, 1, 1); } } while (0)
        for (int t = 0; t < nt; t += 2) { G_ITER1(0, t); G_ITER1(1, t + 1); }
#undef G_ITER1
#undef G_BLK
#undef G_MMA2
#undef G_LDA2
    }
#undef G_STAGE_A
#undef G_STAGE_B
#undef G_LOADX
#undef G_WRITEX
#undef G_LDA
#undef G_LDB
#undef G_MMA
}

struct Args {
    const float* in[22]; float* out; unsigned char* ws; int ph_lo, ph_hi;
};

__device__ __forceinline__ float gelu_tanh(float v) {
    const float u = 0.7978845608028654f * (v + 0.044715f * v * v * v);
    return v * __builtin_amdgcn_rcpf(1.f + __builtin_amdgcn_exp2f(-2.885390081777927f * u));
}
__device__ __forceinline__ float silu_f(float v) { return v * __builtin_amdgcn_rcpf(1.f + __builtin_amdgcn_exp2f(-1.4426950408889634f * v)); }

__device__ __forceinline__ void norm_token(int lane, const float* xrow, const bf16_t* y0, const bf16_t* y1, const float* gate, float* xout,
                                           const float* g, const float* shift, const float* scale, bf16_t* hout, float* fout) {
    f32x4 v[8]; float ss = 0.f;
#pragma unroll
    for (int j = 0; j < 8; ++j) {
        const int d = 4 * lane + 256 * j;
        f32x4 xv = *(const f32x4*)(xrow + d);
        if (y0) {
            const u32x2 a = *(const u32x2*)(y0 + d), b = *(const u32x2*)(y1 + d); const f32x4 gt = *(const f32x4*)(gate + d);
            xv[0] += gt[0] * (bf_lo(a.x) + bf_lo(b.x)); xv[1] += gt[1] * (bf_hi(a.x) + bf_hi(b.x));
            xv[2] += gt[2] * (bf_lo(a.y) + bf_lo(b.y)); xv[3] += gt[3] * (bf_hi(a.y) + bf_hi(b.y));
            if (xout) *(f32x4*)(xout + d) = xv;
        }
        v[j] = xv; ss += (xv[0] * xv[0] + xv[1] * xv[1]) + (xv[2] * xv[2] + xv[3] * xv[3]);
    }
    const float rstd = rsqrtf(wave_sum(ss) * (1.f / D) + EPS);
#pragma unroll
    for (int j = 0; j < 8; ++j) {
        const int d = 4 * lane + 256 * j;
        const f32x4 gg = *(const f32x4*)(g + d); f32x4 h = v[j] * rstd * gg;
        if (scale) { const f32x4 sc = *(const f32x4*)(scale + d), sh = *(const f32x4*)(shift + d); h = h * (1.f + sc) + sh; }
        if (hout) { u32x2 w; w.x = cvt_pk(h[0], h[1]); w.y = cvt_pk(h[2], h[3]); *(u32x2*)(hout + d) = w; }
        if (fout) *(f32x4*)(fout + d) = h;
    }
}

__global__ void __launch_bounds__(512, 2) mk_fwd(Args args) {
    extern __shared__ __attribute__((aligned(16))) unsigned char lds_raw[];
    LAS unsigned char* lds = (LAS unsigned char*)lds_raw;
    volatile LAS unsigned* MISC = (volatile LAS unsigned*)(lds + MISC_OFF);
    const int wid = __builtin_amdgcn_readfirstlane((int)threadIdx.x >> 6);
#define GET_TID const int lane = opaque_lane(); const int tid = wid * 64 + lane; (void)tid
    const int G = gridDim.x; const int bx = blockIdx.x;
    const int vcu = (G % 8 == 0) ? (bx % 8) * (G / 8) + bx / 8 : bx;
    unsigned char* ws = args.ws;
    unsigned* ctl = (unsigned*)(ws + WS_CTL);
    XcdBarrier bar;
    { GET_TID; if (tid < 4) MISC[tid] = 0u;
      __syncthreads();
      bar = xcd_barrier_post(ctl + CW_BAR, MISC, tid); }
    const int lo = args.ph_lo, hi = args.ph_hi;
#ifndef PH_MASK
#define PH_MASK 0x1FFFF
#endif
#define IN(k) (((PH_MASK >> (k)) & 1) && lo <= (k) && (k) < hi)
#define SEAM(k) do { if (IN(k) && IN((k) + 1)) { GET_TID; xcd_barrier(bar, tid); } } while (0)

#define x_in     (args.in[0])
#define c_in     (args.in[1])
#define g_norm1  (args.in[2])
#define g_norm2  (args.in[3])
#define w_ada    (args.in[4])
#define b_ada    (args.in[5])
#define fa_w_in  (args.in[6])
#define fa_w_out (args.in[7])
#define sg_w_in  (args.in[8])
#define sg_b_in  (args.in[9])
#define sg_g_v   (args.in[10])
#define sg_w_s   (args.in[11])
#define sg_b_s   (args.in[12])
#define sg_w_out (args.in[13])
#define w_group  (args.in[14])
#define b_group  (args.in[15])
#define w_router (args.in[16])
#define b_router (args.in[17])
#define w_gate   (args.in[18])
#define w_up     (args.in[19])
#define w_down   (args.in[20])
#define g_final  (args.in[21])
#define mod    ((float*)(args.ws + WS_MOD))
#define Wfin   ((bf16_t*)(args.ws + WS_WFIN))
#define Wfout  ((bf16_t*)(args.ws + WS_WFOUT))
#define Wsgin  ((bf16_t*)(args.ws + WS_WSGIN))
#define Wsgout ((bf16_t*)(args.ws + WS_WSGOUT))
#define DFTC   ((bf16_t*)(args.ws + WS_DFTC))
#define DFTS   ((bf16_t*)(args.ws + WS_DFTS))
#define hA     ((bf16_t*)(args.ws + WS_HA))
#define zB     ((bf16_t*)(args.ws + WS_ZB))
#define T2     ((bf16_t*)(args.ws + WS_T2))
#define fB     ((bf16_t*)(args.ws + WS_FB))
#define ubuf   T2
#define vbuf   (T2 + (size_t)T * D)
#define xa     ((float*)(args.ws + WS_XA))
#define xb     ((float*)(args.ws + WS_XB))
#define act    ((bf16_t*)(args.ws + WS_ACT))
#define ybuf   ((bf16_t*)(args.ws + WS_YB))
#define vss    ((float*)(args.ws + WS_VSS))
#define lists  ((int*)(args.ws + WS_LISTS))
#define tokw   ((float*)(args.ws + WS_TOKW))
#define LANE_SETUP GET_TID; const GemmLane L = make_lane(tid); const int wr = L.wr, wc = L.wc, fr = L.fr, fq = L.fq; f32x4 acc[2][2][4][2]; (void)wr; (void)wc; (void)fr; (void)fq

    if (IN(0)) { GET_TID;
        {
            LAS float* ca = (LAS float*)lds;
            for (int i = tid; i < NB * D; i += 512) { const float v = c_in[i]; ca[i] = v / (1.f + __expf(-v)); }
            __syncthreads();
            for (int slab = bx; slab < 256; slab += G) {
            const int col0 = slab * 96; const int l = col0 / (6 * D), j0 = col0 % (6 * D);
            const int sub = lane / 24, c4 = lane % 24; const bool act_lane = lane < 48;
            f32x4 a0 = {0, 0, 0, 0}, a1 = a0, a2 = a0, a3 = a0;
            if (act_lane) {
                const float* wp = w_ada + (size_t)l * D * 6 * D + j0 + 4 * c4;
#pragma unroll 8
                for (int it = 0; it < 128; ++it) {
                    const int k = 256 * wid + 2 * it + sub;
                    const f32x4 wv = *(const f32x4*)(wp + (size_t)k * 6 * D);
                    a0 += ca[k] * wv; a1 += ca[D + k] * wv; a2 += ca[2 * D + k] * wv; a3 += ca[3 * D + k] * wv;
                }
            }
            __syncthreads();
            LAS float* red = (LAS float*)(lds + 32768);
            if (act_lane) { LAS f32x4* r = (LAS f32x4*)(red + (wid * 48 + lane) * 16); r[0] = a0; r[1] = a1; r[2] = a2; r[3] = a3; }
            __syncthreads();
            if (tid < 384) {
                const int b = tid / 96, cc = tid % 96, c4i = cc >> 2, e = cc & 3; float s = 0.f;
#pragma unroll
                for (int w = 0; w < 8; ++w)
#pragma unroll
                    for (int sb = 0; sb < 2; ++sb) s += red[(w * 48 + sb * 24 + c4i) * 16 + b * 4 + e];
                mod[((size_t)l * NB + b) * 6 * D + j0 + cc] = s + b_ada[l * 6 * D + j0 + cc];
            }
            __syncthreads();
            }
        }
        {
            const size_t gtid = (size_t)vcu * 512 + tid, gstride = (size_t)G * 512;
            auto conv = [&](const float* src, bf16_t* dst, size_t n8) {
                for (size_t i = gtid; i < n8; i += gstride) { const f32x4 a = *(const f32x4*)(src + i * 8), b = *(const f32x4*)(src + i * 8 + 4);
                    u32x4 w; w.x = cvt_pk(a[0], a[1]); w.y = cvt_pk(a[2], a[3]); w.z = cvt_pk(b[0], b[1]); w.w = cvt_pk(b[2], b[3]); *(u32x4*)(dst + i * 8) = w; } };
            conv(fa_w_in, Wfin, (size_t)D * D / 8); conv(fa_w_out, Wfout, (size_t)D * D / 8);
            conv(sg_w_in, Wsgin, (size_t)D * 2 * D / 8); conv(sg_w_out, Wsgout, (size_t)D * D / 8);
            for (size_t i = gtid; i < (size_t)CG * 1024 / 8; i += gstride) {
                const int n2 = (int)(i / 128), j0 = (int)(i % 128) * 8; float v[8];
#pragma unroll
                for (int e = 0; e < 8; ++e) { const int j = j0 + e, k2 = j & 511; const float ang = (float)((k2 * n2) & 511) * (2.0f / 512.0f); v[e] = (j < 512 ? cospif(ang) : sinpif(ang)) * (1.0f / 32.0f); }
                u32x4 w; w.x = cvt_pk(v[0], v[1]); w.y = cvt_pk(v[2], v[3]); w.z = cvt_pk(v[4], v[5]); w.w = cvt_pk(v[6], v[7]); *(u32x4*)(DFTC + i * 8) = w;
            }
            for (size_t i = gtid; i < (size_t)S * 4096 / 8; i += gstride) {
                const int k1 = (int)(i / 512), kk0 = (int)(i % 512) * 8; float v[8];
#pragma unroll
                for (int e = 0; e < 8; ++e) { const int kk = kk0 + e, n1 = kk & 2047; const float ang = (float)((k1 * n1) & 2047) * (2.0f / 2048.0f); v[e] = (kk < 2048 ? cospif(ang) : -sinpif(ang)) * (1.0f / 32.0f); }
                u32x4 w; w.x = cvt_pk(v[0], v[1]); w.y = cvt_pk(v[2], v[3]); w.z = cvt_pk(v[4], v[5]); w.w = cvt_pk(v[6], v[7]); *(u32x4*)(DFTS + i * 8) = w;
            }
        }
    }
    SEAM(0);

    if (IN(1)) { GET_TID;
        for (int t = vcu * 8 + wid; t < T; t += G * 8) {
            const int b = t / S; const float* m = mod + (size_t)b * 6 * D;
            norm_token(lane, x_in + (size_t)t * D, nullptr, nullptr, nullptr, nullptr, g_norm1, m, m + D, hA + (size_t)t * D, nullptr);
        }
    }
    SEAM(1);

#define DENSE_UNIT(Aptr, lda, Bptr, ldb, Kdim) do { \
        unsigned _vo[2][2]; _Pragma("unroll") for (int _h = 0; _h < 2; ++_h) _Pragma("unroll") for (int _i = 0; _i < 2; ++_i) _vo[_h][_i] = (unsigned)(((_h * 128 + L.Ra[_i]) * (lda) + L.Ca[_i]) * 2); \
        gemm_unit<0, 2>(lds, L, (const char*)(Aptr), _vo, (const char*)(Bptr), nullptr, (unsigned)((ldb) * 2), (Kdim) / 64, acc); } while (0)

    if (IN(2)) { LANE_SETUP;
        for (int u = vcu; u < 32 * 8; u += G) {
            const int pm = u >> 3, pn = u & 7;
            DENSE_UNIT(hA + (size_t)pm * 256 * D, D, Wfin + pn * 256, D, D);
#pragma unroll
            for (int ai = 0; ai < 2; ++ai)
#pragma unroll
                for (int m = 0; m < 4; ++m) { const int row = pm * 256 + ai * 128 + wr * 64 + m * 16 + fr;
#pragma unroll
                    for (int bj = 0; bj < 2; ++bj)
#pragma unroll
                        for (int n = 0; n < 2; ++n) { const int col = pn * 256 + bj * 128 + wc * 32 + n * 16 + 4 * fq; const f32x4 v = acc[ai][bj][m][n];
                            u32x2 w; w.x = cvt_pk(v[0], v[1]); w.y = cvt_pk(v[2], v[3]); *(u32x2*)(zB + (size_t)row * D + col) = w; } }
        }
    }
    SEAM(2);

    if (IN(3)) { LANE_SETUP;
        for (int u = vcu; u < 32 * 16; u += G) {
            const int pm = u >> 4, pn = u & 15, g = pn >> 2, ct = pn & 3;
            DENSE_UNIT(zB + (size_t)pm * 256 * D + g * CG, D, DFTC + ct * 256, 1024, CG);
            const int which = ct >> 1; const int cbase = g * CG + (ct & 1) * 256;
#pragma unroll
            for (int ai = 0; ai < 2; ++ai)
#pragma unroll
                for (int m = 0; m < 4; ++m) { const int row = pm * 256 + ai * 128 + wr * 64 + m * 16 + fr; const int b = row >> 11, n1 = row & 2047;
                    bf16_t* orow = T2 + ((size_t)(b * 2 + which) * S + n1) * D + cbase;
#pragma unroll
                    for (int bj = 0; bj < 2; ++bj)
#pragma unroll
                        for (int n = 0; n < 2; ++n) { const int col = bj * 128 + wc * 32 + n * 16 + 4 * fq; const f32x4 v = acc[ai][bj][m][n];
                            u32x2 w; w.x = cvt_pk(v[0], v[1]); w.y = cvt_pk(v[2], v[3]); *(u32x2*)(orow + col) = w; } }
        }
    }
    SEAM(3);

    if (IN(4)) { LANE_SETUP;
        for (int u = vcu; u < 32 * 8; u += G) {
            const int pm = u >> 3, pn = u & 7, b = pm >> 3, pk = pm & 7;
            DENSE_UNIT(DFTS + (size_t)pk * 256 * 4096, 4096, T2 + (size_t)b * 2 * S * D + pn * 256, D, 4096);
#pragma unroll
            for (int ai = 0; ai < 2; ++ai)
#pragma unroll
                for (int m = 0; m < 4; ++m) { const int row = pm * 256 + ai * 128 + wr * 64 + m * 16 + fr;
#pragma unroll
                    for (int bj = 0; bj < 2; ++bj)
#pragma unroll
                        for (int n = 0; n < 2; ++n) { const int col = pn * 256 + bj * 128 + wc * 32 + n * 16 + 4 * fq; const f32x4 v = acc[ai][bj][m][n];
                            u32x2 w; w.x = cvt_pk(v[0], v[1]); w.y = cvt_pk(v[2], v[3]); *(u32x2*)(fB + (size_t)row * D + col) = w; } }
        }
    }
    SEAM(4);

#define RESID_EPI(basep, gatep, dstp) do { \
        _Pragma("unroll") for (int ai = 0; ai < 2; ++ai) _Pragma("unroll") for (int m = 0; m < 4; ++m) { const int row = pm * 256 + ai * 128 + wr * 64 + m * 16 + fr; const int b = row >> 11; \
            _Pragma("unroll") for (int bj = 0; bj < 2; ++bj) _Pragma("unroll") for (int n = 0; n < 2; ++n) { const int col = pn * 256 + bj * 128 + wc * 32 + n * 16 + 4 * fq; \
                const f32x4 gt = *(const f32x4*)((gatep) + (size_t)b * 6 * D + col); const f32x4 bs = *(const f32x4*)((basep) + (size_t)row * D + col); \
                *(f32x4*)((dstp) + (size_t)row * D + col) = bs + gt * acc[ai][bj][m][n]; } } } while (0)

    if (IN(5)) { LANE_SETUP;
        for (int u = vcu; u < 32 * 8; u += G) {
            const int pm = u >> 3, pn = u & 7;
            DENSE_UNIT(fB + (size_t)pm * 256 * D, D, Wfout + pn * 256, D, D);
            RESID_EPI(x_in, mod + 2 * D, xa);
        }
    }
    SEAM(5);

    auto route_phase = [&](int l, const float* xsrc) { GET_TID;
        const float* g2 = g_norm2 + l * D; const float* m_l = mod + (size_t)l * NB * 6 * D;
        const float* wg = w_group + (size_t)l * D * NG; const float* wrt = w_router + (size_t)l * D * NE;
        const float* bg = b_group + l * NG; const float* brt = b_router + l * NE;
        unsigned* counts = ctl + CW_COUNTS + l * 32; int* lst = lists + (size_t)l * NE * T; float* tw = tokw + (size_t)l * T * 2;
        LAS float* wl = (LAS float*)lds;
        LAS float* hs = (LAS float*)(lds + 40960) + wid * D;
#pragma unroll 1
        for (int t0 = vcu * 8; t0 < T; t0 += G * 8) {
            const int tk = t0 + wid; const int b = tk / S;
            {
                const float* xr = xsrc + (size_t)tk * D; float ss = 0.f; float hv[32];
#pragma unroll
                for (int i = 0; i < 32; ++i) { hv[i] = xr[64 * i + lane]; ss += hv[i] * hv[i]; }
                const float rstd = rsqrtf(wave_sum(ss) * (1.f / D) + EPS);
                const float* scp = m_l + (size_t)b * 6 * D + 4 * D; const float* shp = m_l + (size_t)b * 6 * D + 3 * D;
#pragma unroll
                for (int i = 0; i < 32; ++i) { const int d = 64 * i + lane; const float hh = hv[i] * rstd * g2[d] * (1.f + scp[d]) + shp[d];
                    hs[d] = hh; hA[(size_t)tk * D + d] = (bf16_t)(cvt_pk(hh, 0.f) & 0xffffu);
                    if ((i & 7) == 7) asm volatile("" ::: "memory"); }
            }
            f32x2 a2[18];
#pragma unroll
            for (int o = 0; o < 18; ++o) a2[o] = (f32x2){0.f, 0.f};
#pragma unroll 1
            for (int j = 0; j < 8; ++j) {
                __syncthreads();
                for (int i = tid; i < 256 * 8; i += 512) { const int ch = i >> 3, c4 = i & 7; const f32x4 v = *(const f32x4*)(wrt + (size_t)(256 * j + ch) * NE + 4 * c4); *(LAS f32x4*)(wl + ch * 36 + 4 + 4 * c4) = v; }
                if (tid < 256) { const f32x4 v = *(const f32x4*)(wg + (size_t)(256 * j + tid) * NG); *(LAS f32x4*)(wl + tid * 36) = v; }
                __syncthreads();
#pragma unroll
                for (int cc = 0; cc < 4; ++cc) {
                    const float hh = hs[256 * j + 64 * cc + lane]; const f32x2 h2 = (f32x2){hh, hh};
                    const LAS f32x4* wrow = (const LAS f32x4*)(wl + (cc * 64 + lane) * 36);
#pragma unroll
                    for (int q = 0; q < 9; ++q) { const f32x4 wv = wrow[q]; a2[2 * q] += h2 * (f32x2){wv[0], wv[1]}; a2[2 * q + 1] += h2 * (f32x2){wv[2], wv[3]}; }
                }
            }
            float lg[36];
#pragma unroll
            for (int o = 0; o < 18; ++o) { lg[2 * o] = wave_sum(a2[o][0]); lg[2 * o + 1] = wave_sum(a2[o][1]); }
            float gl[4];
#pragma unroll
            for (int i = 0; i < 4; ++i) gl[i] = lg[i] + bg[i];
            int gi = 0; float gm = gl[0];
#pragma unroll
            for (int i = 1; i < 4; ++i) if (gl[i] > gm) { gm = gl[i]; gi = i; }
            float se = 0.f;
#pragma unroll
            for (int i = 0; i < 4; ++i) se += __expf(gl[i] - gm);
            const float gw = 1.f / se;
            float el[8];
#pragma unroll
            for (int i = 0; i < 8; ++i) { float v = 0.f;
#pragma unroll
                for (int gg = 0; gg < 4; ++gg) v = (gi == gg) ? (lg[4 + gg * 8 + i] + brt[gg * 8 + i]) : v;
                el[i] = v; }
            int i0 = 0; float v0 = el[0];
#pragma unroll
            for (int i = 1; i < 8; ++i) if (el[i] > v0) { v0 = el[i]; i0 = i; }
            int i1 = 0; float v1 = -3.4e38f;
#pragma unroll
            for (int i = 0; i < 8; ++i) if (i != i0 && el[i] > v1) { v1 = el[i]; i1 = i; }
            const float e1 = __expf(v1 - v0); const float p0 = 1.f / (1.f + e1), p1 = e1 / (1.f + e1);
            if (lane == 0) {
                const int ex0 = gi * EPG + i0, ex1 = gi * EPG + i1;
                tw[tk * 2 + 0] = p0 * gw; tw[tk * 2 + 1] = p1 * gw;
                const unsigned q0 = atomicAdd(&counts[ex0], 1u); lst[(size_t)ex0 * T + q0] = tk * 2 + 0;
                const unsigned q1 = atomicAdd(&counts[ex1], 1u); lst[(size_t)ex1 * T + q1] = tk * 2 + 1;
            }
        }
        __syncthreads();
    };

    auto moe1_phase = [&](int l) { LANE_SETUP;
        const unsigned* counts = ctl + CW_COUNTS + l * 32; const int* lst = lists + (size_t)l * NE * T;
        const float* WG = w_gate + (size_t)l * NE * D * DE; const float* WU = w_up + (size_t)l * NE * D * DE;
        int ustart = 0, base = 0;
#pragma unroll 1
        for (int e = 0; e < NE; ++e) {
            const int cnt = (int)counts[e]; const int nrt = (cnt + 255) >> 8; const int nun = nrt * 4;
            int first = vcu - (ustart % G); if (first < 0) first += G;
#pragma unroll 1
            for (int r = first; r < nun; r += G) {
                const int ct = r / nrt, rt = r % nrt;
                unsigned vo[2][2];
#pragma unroll
                for (int hh = 0; hh < 2; ++hh)
#pragma unroll
                    for (int i = 0; i < 2; ++i) { const int mrow = rt * 256 + hh * 128 + L.Ra[i]; const int ent = (mrow < cnt) ? lst[(size_t)e * T + mrow] : 0; vo[hh][i] = (unsigned)(((ent >> 1) * D + L.Ca[i]) * 2); }
                const float* wgp = WG + (size_t)e * D * DE + ct * 128; const float* wup = WU + (size_t)e * D * DE + ct * 128;
                gemm_unit<1, 2>(lds, L, (const char*)hA, vo, (const char*)wgp, (const char*)wup, (unsigned)(DE * 4), D / 64, acc);
#pragma unroll
                for (int ai = 0; ai < 2; ++ai)
#pragma unroll
                    for (int m = 0; m < 4; ++m) { const int mrow = rt * 256 + ai * 128 + wr * 64 + m * 16 + fr;
                        if (mrow < cnt) { bf16_t* orow = act + (size_t)(base + mrow) * DE + ct * 128;
#pragma unroll
                            for (int n = 0; n < 2; ++n) { const f32x4 gv = acc[ai][0][m][n], uv = acc[ai][1][m][n];
                                u32x2 w; w.x = cvt_pk(silu_f(gv[0]) * uv[0], silu_f(gv[1]) * uv[1]); w.y = cvt_pk(silu_f(gv[2]) * uv[2], silu_f(gv[3]) * uv[3]);
                                *(u32x2*)(orow + wc * 32 + n * 16 + 4 * fq) = w; } }
                        asm volatile("" ::: "memory"); }
            }
            ustart += nun; base += cnt;
        }
    };
    auto moe2_phase = [&](int l) { LANE_SETUP;
        const unsigned* counts = ctl + CW_COUNTS + l * 32; const int* lst = lists + (size_t)l * NE * T; const float* tw = tokw + (size_t)l * T * 2;
        const float* WD = w_down + (size_t)l * NE * DE * D;
        int ustart = 0, base = 0;
#pragma unroll 1
        for (int e = 0; e < NE; ++e) {
            const int cnt = (int)counts[e]; const int nrt = (cnt + 255) >> 8; const int nun = nrt * 8;
            int first = vcu - (ustart % G); if (first < 0) first += G;
#pragma unroll 1
            for (int r = first; r < nun; r += G) {
                const int ct = r / nrt, rt = r % nrt;
                unsigned vo[2][2];
#pragma unroll
                for (int hh = 0; hh < 2; ++hh)
#pragma unroll
                    for (int i = 0; i < 2; ++i) vo[hh][i] = (unsigned)(((hh * 128 + L.Ra[i]) * DE + L.Ca[i]) * 2);
                const float* wdp = WD + (size_t)e * DE * D + ct * 256;
                gemm_unit<1, 2>(lds, L, (const char*)(act + (size_t)(base + rt * 256) * DE), vo, (const char*)wdp, (const char*)(wdp + 128), (unsigned)(D * 4), DE / 64, acc);
#pragma unroll
                for (int ai = 0; ai < 2; ++ai)
#pragma unroll
                    for (int m = 0; m < 4; ++m) { const int mrow = rt * 256 + ai * 128 + wr * 64 + m * 16 + fr;
                        if (mrow < cnt) { const int ent = lst[(size_t)e * T + mrow]; const float w8 = tw[ent]; bf16_t* orow = ybuf + (size_t)ent * D + ct * 256;
#pragma unroll
                            for (int bj = 0; bj < 2; ++bj)
#pragma unroll
                                for (int n = 0; n < 2; ++n) { const f32x4 v = acc[ai][bj][m][n] * w8;
                                    u32x2 w; w.x = cvt_pk(v[0], v[1]); w.y = cvt_pk(v[2], v[3]); *(u32x2*)(orow + bj * 128 + wc * 32 + n * 16 + 4 * fq) = w; } }
                        asm volatile("" ::: "memory"); }
            }
            ustart += nun; base += cnt;
        }
    };

    if (IN(6)) route_phase(0, xa);
    SEAM(6);
    if (IN(7)) moe1_phase(0);
    SEAM(7);
    if (IN(8)) moe2_phase(0);
    SEAM(8);

    if (IN(9)) { GET_TID;
        const float* m1 = mod + (size_t)NB * 6 * D;
        for (int t = vcu * 8 + wid; t < T; t += G * 8) {
            const int b = t / S;
            norm_token(lane, xa + (size_t)t * D, ybuf + (size_t)t * 2 * D, ybuf + (size_t)t * 2 * D + D, mod + (size_t)b * 6 * D + 5 * D, xb + (size_t)t * D,
                       g_norm1 + D, m1 + (size_t)b * 6 * D, m1 + (size_t)b * 6 * D + D, hA + (size_t)t * D, nullptr);
        }
    }
    SEAM(9);

    if (IN(10)) { LANE_SETUP;
        for (int u = vcu; u < 32 * 16; u += G) {
            const int pm = u >> 4, pn = u & 15;
            DENSE_UNIT(hA + (size_t)pm * 256 * D, D, Wsgin + pn * 256, 2 * D, D);
            const bool isv = pn >= 8; bf16_t* dst = isv ? vbuf : ubuf; const int cb = (pn & 7) * 256;
#pragma unroll
            for (int ai = 0; ai < 2; ++ai)
#pragma unroll
                for (int m = 0; m < 4; ++m) { const int row = pm * 256 + ai * 128 + wr * 64 + m * 16 + fr; float ss = 0.f;
#pragma unroll
                    for (int bj = 0; bj < 2; ++bj)
#pragma unroll
                        for (int n = 0; n < 2; ++n) { const int cl = bj * 128 + wc * 32 + n * 16 + 4 * fq; const f32x4 bi = *(const f32x4*)(sg_b_in + pn * 256 + cl); f32x4 v = acc[ai][bj][m][n] + bi;
                            v[0] = gelu_tanh(v[0]); v[1] = gelu_tanh(v[1]); v[2] = gelu_tanh(v[2]); v[3] = gelu_tanh(v[3]);
                            ss += (v[0] * v[0] + v[1] * v[1]) + (v[2] * v[2] + v[3] * v[3]);
                            u32x2 w; w.x = cvt_pk(v[0], v[1]); w.y = cvt_pk(v[2], v[3]); *(u32x2*)(dst + (size_t)row * D + cb + cl) = w; }
                    if (isv) { ss += __shfl_xor(ss, 16); ss += __shfl_xor(ss, 32); if (fq == 0) vss[(size_t)row * 32 + (pn - 8) * 4 + wc] = ss; } }
        }
    }
    SEAM(10);

    if (IN(11)) { LANE_SETUP;
        LAS float* rs = (LAS float*)(lds + MISC_OFF + 1024);
        for (int u = vcu; u < 64 * 8; u += G) {
            const int ch = u >> 3, hd = u & 7;
            WAIT_V(0); WAIT_L0(); __syncthreads();
            if (tid < 128) { const f32x4* p = (const f32x4*)(vss + (size_t)(ch * CH + tid) * 32); float s = 0.f;
#pragma unroll
                for (int i = 0; i < 8; ++i) { const f32x4 v = p[i]; s += (v[0] + v[1]) + (v[2] + v[3]); }
                rs[tid] = rsqrtf(s * (1.f / D) + EPS); }
            __syncthreads();
#pragma unroll
            for (int i = 0; i < 4; ++i) { const int idx = tid + i * 512; const int p = idx >> 4, q8 = idx & 15;
                const f32x4 a = *(const f32x4*)(sg_w_s + ((size_t)hd * CH + p) * CH + q8 * 8), b2 = *(const f32x4*)(sg_w_s + ((size_t)hd * CH + p) * CH + q8 * 8 + 4);
                const f32x4 r0 = *(const LAS f32x4*)(rs + q8 * 8), r1 = *(const LAS f32x4*)(rs + q8 * 8 + 4);
                u32x4 w; w.x = cvt_pk(a[0] * r0[0], a[1] * r0[1]); w.y = cvt_pk(a[2] * r0[2], a[3] * r0[3]); w.z = cvt_pk(b2[0] * r1[0], b2[1] * r1[1]); w.w = cvt_pk(b2[2] * r1[2], b2[3] * r1[3]);
                *(LAS u32x4*)(lds + SA_OFF(q8 >> 3, 0) + lds_byte(p, (q8 & 7) * 8)) = w; }
            { const char* Bb = (const char*)(vbuf + (size_t)ch * CH * D + hd * DH);
#pragma unroll
              for (int kt = 0; kt < 2; ++kt)
#pragma unroll
                for (int hh = 0; hh < 2; ++hh)
#pragma unroll
                    for (int i = 0; i < 2; ++i)
                        __builtin_amdgcn_global_load_lds((const unsigned*)(Bb + (size_t)(kt * 64 + L.Rb[i]) * (D * 2) + hh * 256 + L.Cb16[i] * 16), (LAS unsigned*)(lds + SB_OFF(kt, hh) + wid * 1024 + i * 8192), 16, 0, 0); }
            WAIT_V(0); WAIT_L0(); __syncthreads();
            f32x4 ac[2][4][2];
#pragma unroll
            for (int bj = 0; bj < 2; ++bj)
#pragma unroll
                for (int m = 0; m < 4; ++m)
#pragma unroll
                    for (int n = 0; n < 2; ++n) ac[bj][m][n] = (f32x4){0.f, 0.f, 0.f, 0.f};
#pragma unroll
            for (int kt = 0; kt < 2; ++kt) {
                bf16x8 At[4][2];
#pragma unroll
                for (int m = 0; m < 4; ++m)
#pragma unroll
                    for (int k = 0; k < 2; ++k) At[m][k] = *(const LAS bf16x8*)(lds + SA_OFF(kt, 0) + L.aoff + m * 2048 + k * 1024);
#pragma unroll
                for (int bj = 0; bj < 2; ++bj)
#pragma unroll
                    for (int n = 0; n < 2; ++n)
#pragma unroll
                        for (int k = 0; k < 2; ++k) {
                            const s16x4 lo4 = __builtin_amdgcn_ds_read_tr16_b64_v4i16((LAS s16x4*)(lds + SB_OFF(kt, bj) + L.boff[n] + k * 8192));
                            const s16x4 hi4 = __builtin_amdgcn_ds_read_tr16_b64_v4i16((LAS s16x4*)(lds + SB_OFF(kt, bj) + L.boff[n] + k * 8192 + 1024));
                            const bf16x8 bfrag = __builtin_shufflevector(lo4, hi4, 0, 1, 2, 3, 4, 5, 6, 7);
#pragma unroll
                            for (int m = 0; m < 4; ++m) ac[bj][m][n] = __builtin_amdgcn_mfma_f32_16x16x32_bf16(bfrag, At[m][k], ac[bj][m][n], 0, 0, 0);
                        }
            }
#pragma unroll
            for (int m = 0; m < 4; ++m) { const int p = wr * 64 + m * 16 + fr; const size_t tok = (size_t)ch * CH + p; const float bs = sg_b_s[hd * CH + p];
#pragma unroll
                for (int bj = 0; bj < 2; ++bj)
#pragma unroll
                    for (int n = 0; n < 2; ++n) { const int d = hd * DH + bj * 128 + wc * 32 + n * 16 + 4 * fq; const f32x4 gv = *(const f32x4*)(sg_g_v + d); const u32x2 uu = *(const u32x2*)(ubuf + tok * D + d);
                        const f32x4 mx = gv * ac[bj][m][n] + bs;
                        u32x2 w; w.x = cvt_pk(bf_lo(uu.x) * mx[0], bf_hi(uu.x) * mx[1]); w.y = cvt_pk(bf_lo(uu.y) * mx[2], bf_hi(uu.y) * mx[3]); *(u32x2*)(zB + tok * D + d) = w; } }
        }
        WAIT_V(0); WAIT_L0(); __syncthreads();
    }
    SEAM(11);

    if (IN(12)) { LANE_SETUP;
        for (int u = vcu; u < 32 * 8; u += G) {
            const int pm = u >> 3, pn = u & 7;
            DENSE_UNIT(zB + (size_t)pm * 256 * D, D, Wsgout + pn * 256, D, D);
            RESID_EPI(xb, mod + (size_t)NB * 6 * D + 2 * D, xa);
        }
    }
    SEAM(12);

    if (IN(13)) route_phase(1, xa);
    SEAM(13);
    if (IN(14)) moe1_phase(1);
    SEAM(14);
    if (IN(15)) moe2_phase(1);
    SEAM(15);

    if (IN(16)) { GET_TID;
        const float* m1 = mod + (size_t)NB * 6 * D;
        for (int t = vcu * 8 + wid; t < T; t += G * 8) {
            const int b = t / S;
            norm_token(lane, xa + (size_t)t * D, ybuf + (size_t)t * 2 * D, ybuf + (size_t)t * 2 * D + D, m1 + (size_t)b * 6 * D + 5 * D, nullptr,
                       g_final, nullptr, nullptr, nullptr, args.out + (size_t)t * D);
        }
    }
#undef IN
#undef SEAM
}
}

extern "C" void kernel_launch(void* const* d_in, const int* in_sizes, int n_in, void* d_out, int out_size, void* d_ws, size_t ws_size, hipStream_t stream) {
    using namespace mk;
    static int grid = 0;
    if (grid == 0) {
        if (n_in != 22 || ws_size < WS_END) { fprintf(stderr, "kernel_launch: unexpected inputs (n_in %d, ws %zu)\n", n_in, ws_size); grid = -1; return; }
        int dev = 0, cus = 0, per_cu = 0;
        hipGetDevice(&dev); hipDeviceGetAttribute(&cus, hipDeviceAttributeMultiprocessorCount, dev);
        if (hipFuncSetAttribute((const void*)mk_fwd, hipFuncAttributeMaxDynamicSharedMemorySize, LDS_BYTES) != hipSuccess) { fprintf(stderr, "kernel_launch: hipFuncSetAttribute failed\n"); grid = -1; return; }
        if (hipOccupancyMaxActiveBlocksPerMultiprocessor(&per_cu, (const void*)mk_fwd, 512, LDS_BYTES) != hipSuccess || per_cu < 1) fprintf(stderr, "kernel_launch: occupancy query says %d\n", per_cu);
        (void)hipGetLastError();
        grid = cus;
    }
    if (grid < 0) return;
    hipMemsetAsync((char*)d_ws + WS_CTL, 0, CTL_BYTES, stream);
    Args a{};
    for (int i = 0; i < 22; ++i) a.in[i] = (const float*)d_in[i];
    a.out = (float*)d_out; a.ws = (unsigned char*)d_ws;
#if MK_MULTI
    for (int p = 0; p < NPH; ++p) { a.ph_lo = p; a.ph_hi = p + 1; hipLaunchKernelGGL(mk_fwd, dim3(grid), dim3(512), LDS_BYTES, stream, a); }
#else
    a.ph_lo = 0; a.ph_hi = NPH;
    hipLaunchKernelGGL(mk_fwd, dim3(grid), dim3(512), LDS_BYTES, stream, a);
#endif
}
```

```cpp
#include <hip/hip_runtime.h>
#include <stdint.h>
#include <cstdio>

#ifndef MK_MULTI
#define MK_MULTI 0
#endif

namespace mk {
#define LAS __attribute__((address_space(3)))
typedef unsigned short bf16_t;
typedef short bf16x8 __attribute__((ext_vector_type(8)));
typedef short s16x4 __attribute__((ext_vector_type(4)));
typedef float f32x4 __attribute__((ext_vector_type(4)));
typedef float f32x2 __attribute__((ext_vector_type(2)));
typedef unsigned u32x2 __attribute__((ext_vector_type(2)));
typedef unsigned u32x4 __attribute__((ext_vector_type(4)));

constexpr int D = 2048, NB = 4, S = 2048, T = NB * S;
constexpr int CG = 512;
constexpr int HEADS = 8, CH = 128, DH = 256;
constexpr int NG = 4, EPG = 8, NE = 32, DE = 512;
constexpr float EPS = 1e-6f;
constexpr int NPH = 17;

constexpr size_t MiB = 1u << 20;
constexpr size_t WS_CTL = 0, CTL_BYTES = 1 * MiB;
constexpr size_t WS_MOD = 1 * MiB;
constexpr size_t WS_WFIN = 2 * MiB;
constexpr size_t WS_WFOUT = 10 * MiB;
constexpr size_t WS_WSGIN = 18 * MiB;
constexpr size_t WS_WSGOUT = 34 * MiB;
constexpr size_t WS_DFTC = 42 * MiB;
constexpr size_t WS_DFTS = 44 * MiB;
constexpr size_t WS_HA = 60 * MiB;
constexpr size_t WS_ZB = 92 * MiB;
constexpr size_t WS_T2 = 124 * MiB;
constexpr size_t WS_FB = 188 * MiB;
constexpr size_t WS_XA = 220 * MiB;
constexpr size_t WS_XB = 284 * MiB;
constexpr size_t WS_ACT = 348 * MiB;
constexpr size_t WS_YB = 366 * MiB;
constexpr size_t WS_VSS = 430 * MiB;
constexpr size_t WS_LISTS = 432 * MiB;
constexpr size_t WS_TOKW = 435 * MiB;
constexpr size_t WS_END = 436 * MiB;
constexpr int CW_COUNTS = 64;
constexpr int CW_BAR = 4096;

constexpr int HTB = 16384;
constexpr int RING_BYTES = 131072;
constexpr int MISC_OFF = RING_BYTES;
constexpr int LDS_BYTES = 147456;
#define SA_OFF(b, h) (((b) * 2 + (h)) * HTB)
#define SB_OFF(b, h) ((4 + (b) * 2 + (h)) * HTB)

#define XB_TMO      128
#define XB_XCNT(j)  (256  + 64 * (j))
#define XB_XSUB(j)  (1280 + 64 * (j))
#define XB_XGEN(j)  (2304 + 64 * (j))
#define XB_TOP      3328
#define XB_TOPGEN   3392
#define XCD_BAR_WORDS 3456
#define XB_SPIN_CAP (1u << 18)
__device__ __forceinline__ unsigned xb_ld(unsigned* p)              { return __hip_atomic_load(p, __ATOMIC_RELAXED, __HIP_MEMORY_SCOPE_AGENT); }
__device__ __forceinline__ unsigned xb_add(unsigned* p, unsigned v) { return __hip_atomic_fetch_add(p, v, __ATOMIC_RELAXED, __HIP_MEMORY_SCOPE_AGENT); }
__device__ __forceinline__ unsigned xb_xcc_id() { return (unsigned)__builtin_amdgcn_s_getreg((3 << 11) | 20) & 0xFu; }
#define XB_SPIN(cond, bar) do { unsigned _sp = 0; while (cond) { __builtin_amdgcn_s_sleep(1); \
    if ((++_sp & 255u) == 0u) { if (xb_ld(&(bar)[XB_TMO])) break; if (_sp > XB_SPIN_CAP) { atomicAdd(&(bar)[XB_TMO], 1u); break; } } } } while (0)
struct XcdBarrier { unsigned* bar; unsigned x; volatile LAS unsigned* st; };
__device__ __forceinline__ XcdBarrier xcd_barrier_post(unsigned* bar, volatile LAS unsigned* st, int tid) {
    XcdBarrier b; b.bar = bar; b.x = xb_xcc_id(); b.st = st;
    if (tid == 0) (void)xb_add(&bar[XB_XCNT(b.x)], 1u);
    return b;
}
__device__ __forceinline__ void xcd_barrier_complete(unsigned* bar, unsigned x, unsigned& nloc, unsigned& nx) {
    const unsigned G = gridDim.x * gridDim.y * gridDim.z;
    unsigned sum, cnt, mine, sp = 0u;
    for (;;) {
        sum = 0u; cnt = 0u; mine = 0u;
#pragma unroll
        for (unsigned j = 0; j < 16; ++j) { const unsigned c = xb_ld(&bar[XB_XCNT(j)]); sum += c; cnt += (c > 0u) ? 1u : 0u; mine = (j == x) ? c : mine; }
        if (sum == G) break;
        __builtin_amdgcn_s_sleep(1);
        if ((++sp & 255u) == 0u) { if (xb_ld(&bar[XB_TMO])) break; if (sp > XB_SPIN_CAP) { atomicAdd(&bar[XB_TMO], 1u); break; } }
    }
    nloc = mine > 0u ? mine : 1u; nx = cnt > 0u ? cnt : 1u;
}
__device__ __forceinline__ void xcd_barrier(const XcdBarrier& b, int tid) {
    asm volatile("s_waitcnt vmcnt(0)" ::: "memory");
    __syncthreads();
    if (tid == 0) {
        unsigned* bar = b.bar;
        __builtin_amdgcn_s_waitcnt(0);
        unsigned nloc = b.st[0], nx = b.st[1];
        if (nloc == 0u) { xcd_barrier_complete(bar, b.x, nloc, nx); b.st[0] = nloc; b.st[1] = nx; }
        const unsigned old = xb_add(&bar[XB_XSUB(b.x)], 1u);
        const unsigned gen = old / nloc;
        if (old + 1u == (gen + 1u) * nloc) {
            __builtin_amdgcn_fence(__ATOMIC_RELEASE, "agent");
            asm volatile("s_waitcnt vmcnt(0)" ::: "memory");
            const unsigned og = xb_add(&bar[XB_TOP], 1u);
            const unsigned tg = og / nx;
            if (og + 1u == (tg + 1u) * nx) xb_add(&bar[XB_TOPGEN], 1u);
            else XB_SPIN(xb_ld(&bar[XB_TOPGEN]) == tg, bar);
            __builtin_amdgcn_fence(__ATOMIC_ACQUIRE, "agent");
            xb_add(&bar[XB_XGEN(b.x)], 1u);
            asm volatile("s_waitcnt vmcnt(0)" ::: "memory");
        } else {
            XB_SPIN(xb_ld(&bar[XB_XGEN(b.x)]) == gen, bar);
            __builtin_amdgcn_fence(__ATOMIC_ACQUIRE, "agent");
            asm volatile("s_waitcnt vmcnt(0)" ::: "memory");
        }
    }
    __syncthreads();
}

__device__ __forceinline__ unsigned cvt_pk(float lo, float hi) { unsigned r; asm("v_cvt_pk_bf16_f32 %0, %1, %2" : "=v"(r) : "v"(lo), "v"(hi)); return r; }
__device__ __forceinline__ float bf_lo(unsigned w) { return __uint_as_float(w << 16); }
__device__ __forceinline__ float bf_hi(unsigned w) { return __uint_as_float(w & 0xffff0000u); }
__device__ __forceinline__ float wave_sum(float v) {
#pragma unroll
    for (int o = 1; o < 64; o <<= 1) v += __shfl_xor(v, o);
    return v;
}
__device__ __forceinline__ int opaque_lane() { int l = (int)__builtin_amdgcn_mbcnt_hi(~0u, __builtin_amdgcn_mbcnt_lo(~0u, 0u)); asm volatile("" : "+v"(l)); return l; }
__device__ __forceinline__ float dpp_add(float v, float w) { return v + w; }
#define DPP_STEP(v, ctrl) v += __builtin_bit_cast(float, __builtin_amdgcn_update_dpp(0, __builtin_bit_cast(int, v), ctrl, 0xf, 0xf, true))
__device__ __forceinline__ float row_sum16(float v) { DPP_STEP(v, 0xB1); DPP_STEP(v, 0x4E); DPP_STEP(v, 0x141); DPP_STEP(v, 0x140); return v; }
#define WAIT_V(n) asm volatile("s_waitcnt vmcnt(" #n ")" ::: "memory")
#define WAIT_L0() asm volatile("s_waitcnt lgkmcnt(0)" ::: "memory")
#define BAR() __builtin_amdgcn_s_barrier()

__device__ __forceinline__ int lds_byte(int r, int c) { const int st = (r >> 4) * 2 + (c >> 5), rr = r & 15, cc = c & 31, ob = rr * 64 + cc * 2; return st * 1024 + (ob ^ (((ob >> 9) & 1) << 5)); }
__device__ __forceinline__ void stage_rc(int b, int& R, int& C) { const int st = b / 1024, sb = b % 1024, swz = sb ^ (((sb >> 9) & 1) << 5); R = (st >> 1) * 16 + swz / 64; C = (st & 1) * 32 + (swz % 64) / 2; }
__device__ __forceinline__ int brow_f(int row) { return (row & 3) | (((row >> 3) & 1) << 2); }

struct GemmLane {
    int wid, lane, wr, wc, fr, fq;
    int Ra[2], Ca[2];
    unsigned aoff;
    unsigned boff[2];
    int Rb[2], Cb16[2];
};
__device__ __forceinline__ GemmLane make_lane(int tid) {
    GemmLane L;
    L.wid = __builtin_amdgcn_readfirstlane(tid >> 6); L.lane = tid & 63; L.wr = L.wid >> 2; L.wc = L.wid & 3; L.fr = L.lane & 15; L.fq = L.lane >> 4;
#pragma unroll
    for (int i = 0; i < 2; ++i) {
        stage_rc(tid * 16 + i * 8192, L.Ra[i], L.Ca[i]);
        const int row = i * 32 + (tid >> 4); const int slot_phys = (tid & 15) >> 1; const int slot_log = slot_phys ^ brow_f(row);
        L.Rb[i] = row; L.Cb16[i] = slot_log * 2 + (tid & 1);
    }
    L.aoff = (unsigned)lds_byte(L.wr * 64 + L.fr, L.fq * 8);
    const int q = (L.lane & 15) >> 2, p = L.lane & 3, f = q | ((L.fq & 1) << 2);
#pragma unroll
    for (int n = 0; n < 2; ++n) L.boff[n] = (unsigned)((8 * L.fq + q) * 256 + 8 * p + (((L.wc * 2 + n) ^ f) * 32));
    return L;
}

template <int BMODE, int NAI>
__device__ __forceinline__ void gemm_unit(LAS unsigned char* lds, const GemmLane& L, const char* Ab, const unsigned (&voffA)[2][2],
                                          const char* B0, const char* B1, unsigned ldb_bytes, int nt, f32x4 (&acc)[2][2][4][2]) {
    const int wid = L.wid, lane = L.lane;
    asm volatile("" : "+s"(nt));
#pragma unroll
    for (int a = 0; a < 2; ++a)
#pragma unroll
        for (int b = 0; b < 2; ++b)
#pragma unroll
            for (int m = 0; m < 4; ++m)
#pragma unroll
                for (int n = 0; n < 2; ++n) acc[a][b][m][n] = (f32x4){0.f, 0.f, 0.f, 0.f};
    bf16x8 At[4][2], Bf0[2][2], Bf1[2][2];
    unsigned voffB[2];
    if (BMODE == 0) {
#pragma unroll
        for (int i = 0; i < 2; ++i) voffB[i] = (unsigned)L.Rb[i] * ldb_bytes + (unsigned)L.Cb16[i] * 16u;
    }
    const char* bp = nullptr; unsigned bw_base = 0;
    if (BMODE == 1) { bp = ((lane >> 5) ? B1 : B0) + (lane & 31) * 16; bw_base = (unsigned)((lane >> 5) * HTB + (wid * 8) * 256 + (lane & 3) * 8); }
    f32x4 X[4], Y[4];

#define G_STAGE_A(buf, kt) do { _Pragma("unroll") for (int _h = 0; _h < NAI; ++_h) _Pragma("unroll") for (int _i = 0; _i < 2; ++_i) \
        __builtin_amdgcn_global_load_lds((const unsigned*)(Ab + (size_t)(kt) * 128 + voffA[_h][_i]), (LAS unsigned*)(lds + SA_OFF(buf, _h) + wid * 1024 + _i * 8192), 16, 0, 0); } while (0)
#define G_STAGE_B(buf, kt) do { const char* _bb = B0 + (size_t)(kt) * 64 * ldb_bytes; _Pragma("unroll") for (int _h = 0; _h < 2; ++_h) _Pragma("unroll") for (int _i = 0; _i < 2; ++_i) \
        __builtin_amdgcn_global_load_lds((const unsigned*)(_bb + _h * 256 + voffB[_i]), (LAS unsigned*)(lds + SB_OFF(buf, _h) + wid * 1024 + _i * 8192), 16, 0, 0); } while (0)
#define G_LOADX(V, j0, kt) do { _Pragma("unroll") for (int _j = 0; _j < 4; ++_j) V[_j] = *(const f32x4*)(bp + (size_t)((kt) * 64 + wid * 8 + (j0) + _j) * ldb_bytes); } while (0)
#define G_WRITEX(V, j0, buf) do { _Pragma("unroll") for (int _j = 0; _j < 4; ++_j) { const int _jj = (j0) + _j; const int _f = (_jj & 3) | ((wid & 1) << 2); \
        u32x2 _w; _w.x = cvt_pk(V[_j][0], V[_j][1]); _w.y = cvt_pk(V[_j][2], V[_j][3]); \
        *(LAS u32x2*)(lds + SB_OFF(buf, 0) + bw_base + _jj * 256 + ((((lane & 31) >> 2) ^ _f) * 32)) = _w; } } while (0)
#define G_LDA(buf, h) do { _Pragma("unroll") for (int _m = 0; _m < 4; ++_m) _Pragma("unroll") for (int _k = 0; _k < 2; ++_k) \
        At[_m][_k] = *(const LAS bf16x8*)(lds + SA_OFF(buf, h) + L.aoff + _m * 2048 + _k * 1024); } while (0)
#define G_LDB(dst, buf, h) do { _Pragma("unroll") for (int _n = 0; _n < 2; ++_n) _Pragma("unroll") for (int _k = 0; _k < 2; ++_k) { \
        const s16x4 _lo = __builtin_amdgcn_ds_read_tr16_b64_v4i16((LAS s16x4*)(lds + SB_OFF(buf, h) + L.boff[_n] + _k * 8192)); \
        const s16x4 _hi = __builtin_amdgcn_ds_read_tr16_b64_v4i16((LAS s16x4*)(lds + SB_OFF(buf, h) + L.boff[_n] + _k * 8192 + 1024)); \
        dst[_n][_k] = __builtin_shufflevector(_lo, _hi, 0, 1, 2, 3, 4, 5, 6, 7); } } while (0)
#define G_MMA(ai, bj, Bt) do { _Pragma("unroll") for (int _m = 0; _m < 4; ++_m) _Pragma("unroll") for (int _n = 0; _n < 2; ++_n) _Pragma("unroll") for (int _k = 0; _k < 2; ++_k) \
        acc[ai][bj][_m][_n] = __builtin_amdgcn_mfma_f32_16x16x32_bf16(Bt[_n][_k], At[_m][_k], acc[ai][bj][_m][_n], 0, 0, 0); } while (0)

    WAIT_V(0); WAIT_L0(); BAR();
    if (BMODE == 0) {
        G_STAGE_A(0, 0); G_STAGE_B(0, 0);
#define G_ITER0(p, t) do { WAIT_V(0); BAR(); \
            if ((t) + 1 < nt) { G_STAGE_A(1 - (p), (t) + 1); G_STAGE_B(1 - (p), (t) + 1); } \
            G_LDB(Bf0, p, 0); G_LDA(p, 0); G_MMA(0, 0, Bf0); G_LDB(Bf1, p, 1); G_MMA(0, 1, Bf1); \
            if (NAI == 2) { G_LDA(p, 1); G_MMA(1, 0, Bf0); G_MMA(1, 1, Bf1); } } while (0)
        for (int t = 0; t < nt; t += 2) { G_ITER0(0, t); G_ITER0(1, t + 1); }
#undef G_ITER0
    } else {
        G_LOADX(X, 0, 0); G_LOADX(Y, 4, 0); G_STAGE_A(0, 0);
        WAIT_V(0);
        G_WRITEX(X, 0, 0); G_WRITEX(Y, 4, 0);
        if (nt > 1) { G_LOADX(X, 0, 1); G_LOADX(Y, 4, 1); }
#define G_LDA2(buf, h, mh) do { _Pragma("unroll") for (int _m = 0; _m < 2; ++_m) _Pragma("unroll") for (int _k = 0; _k < 2; ++_k) \
        At[_m][_k] = *(const LAS bf16x8*)(lds + SA_OFF(buf, h) + L.aoff + ((mh) * 2 + _m) * 2048 + _k * 1024); } while (0)
#define G_MMA2(ai, bj, mh) do { _Pragma("unroll") for (int _m = 0; _m < 2; ++_m) _Pragma("unroll") for (int _n = 0; _n < 2; ++_n) _Pragma("unroll") for (int _k = 0; _k < 2; ++_k) \
        acc[ai][bj][(mh) * 2 + _m][_n] = __builtin_amdgcn_mfma_f32_16x16x32_bf16(Bf0[_n][_k], At[_m][_k], acc[ai][bj][(mh) * 2 + _m][_n], 0, 0, 0); } while (0)
#define G_BLK(p, ai, bj) do { G_LDA2(p, ai, 0); G_MMA2(ai, bj, 0); G_LDA2(p, ai, 1); G_MMA2(ai, bj, 1); } while (0)
#define G_ITER1(p, t) do { const bool _n1 = ((t) + 1 < nt), _n2 = ((t) + 2 < nt); \
            if (_n1) { WAIT_V(8); } else { WAIT_V(0); } WAIT_L0(); BAR(); \
            if (_n1) { G_STAGE_A(1 - (p), (t) + 1); } \
            G_LDB(Bf0, p, 0); G_BLK(p, 0, 0); if (NAI == 2) { G_BLK(p, 1, 0); } \
            if (_n1) { WAIT_V(8); G_WRITEX(X, 0, 1 - (p)); if (_n2) { G_LOADX(X, 0, (t) + 2); } } \
            G_LDB(Bf0, p, 1); G_BLK(p, 0, 1); \
            if (_n1) { if (_n2) { WAIT_V(8); } else { WAIT_V(4); } G_WRITEX(Y, 4, 1 - (p)); if (_n2) { G_LOADX(Y, 4, (t) + 2); } } \
            if (NAI == 2) { G_BLK(p, 1, 1); } } while (0)
        for (int t = 0; t < nt; t += 2) { G_ITER1(0, t); G_ITER1(1, t + 1); }
#undef G_ITER1
#undef G_BLK
#undef G_MMA2
#undef G_LDA2
    }
#undef G_STAGE_A
#undef G_STAGE_B
#undef G_LOADX
#undef G_WRITEX
#undef G_LDA
#undef G_LDB
#undef G_MMA
}

struct Args {
    const float* in[22]; float* out; unsigned char* ws; int ph_lo, ph_hi;
};

__device__ __forceinline__ float gelu_tanh(float v) {
    const float u = 0.7978845608028654f * (v + 0.044715f * v * v * v);
    return v * __builtin_amdgcn_rcpf(1.f + __builtin_amdgcn_exp2f(-2.885390081777927f * u));
}
__device__ __forceinline__ float silu_f(float v) { return v * __builtin_amdgcn_rcpf(1.f + __builtin_amdgcn_exp2f(-1.4426950408889634f * v)); }

__device__ __forceinline__ void norm_token(int lane, const float* xrow, const bf16_t* y0, const bf16_t* y1, const float* gate, float* xout,
                                           const float* g, const float* shift, const float* scale, bf16_t* hout, float* fout) {
    f32x4 v[8]; float ss = 0.f;
#pragma unroll
    for (int j = 0; j < 8; ++j) {
        const int d = 4 * lane + 256 * j;
        f32x4 xv = *(const f32x4*)(xrow + d);
        if (y0) {
            const u32x2 a = *(const u32x2*)(y0 + d), b = *(const u32x2*)(y1 + d); const f32x4 gt = *(const f32x4*)(gate + d);
            xv[0] += gt[0] * (bf_lo(a.x) + bf_lo(b.x)); xv[1] += gt[1] * (bf_hi(a.x) + bf_hi(b.x));
            xv[2] += gt[2] * (bf_lo(a.y) + bf_lo(b.y)); xv[3] += gt[3] * (bf_hi(a.y) + bf_hi(b.y));
            if (xout) *(f32x4*)(xout + d) = xv;
        }
        v[j] = xv; ss += (xv[0] * xv[0] + xv[1] * xv[1]) + (xv[2] * xv[2] + xv[3] * xv[3]);
    }
    const float rstd = rsqrtf(wave_sum(ss) * (1.f / D) + EPS);
#pragma unroll
    for (int j = 0; j < 8; ++j) {
        const int d = 4 * lane + 256 * j;
        const f32x4 gg = *(const f32x4*)(g + d); f32x4 h = v[j] * rstd * gg;
        if (scale) { const f32x4 sc = *(const f32x4*)(scale + d), sh = *(const f32x4*)(shift + d); h = h * (1.f + sc) + sh; }
        if (hout) { u32x2 w; w.x = cvt_pk(h[0], h[1]); w.y = cvt_pk(h[2], h[3]); *(u32x2*)(hout + d) = w; }
        if (fout) *(f32x4*)(fout + d) = h;
    }
}

__global__ void __launch_bounds__(512, 2) mk_fwd(Args args) {
    extern __shared__ __attribute__((aligned(16))) unsigned char lds_raw[];
    LAS unsigned char* lds = (LAS unsigned char*)lds_raw;
    volatile LAS unsigned* MISC = (volatile LAS unsigned*)(lds + MISC_OFF);
    const int wid = __builtin_amdgcn_readfirstlane((int)threadIdx.x >> 6);
#define GET_TID const int lane = opaque_lane(); const int tid = wid * 64 + lane; (void)tid
    const int G = gridDim.x; const int bx = blockIdx.x;
    const int vcu = (G % 8 == 0) ? (bx % 8) * (G / 8) + bx / 8 : bx;
    unsigned char* ws = args.ws;
    unsigned* ctl = (unsigned*)(ws + WS_CTL);
    XcdBarrier bar;
    { GET_TID; if (tid < 4) MISC[tid] = 0u;
      __syncthreads();
      bar = xcd_barrier_post(ctl + CW_BAR, MISC, tid); }
    const int lo = args.ph_lo, hi = args.ph_hi;
#ifndef PH_MASK
#define PH_MASK 0x1FFFF
#endif
#define IN(k) (((PH_MASK >> (k)) & 1) && lo <= (k) && (k) < hi)
#ifndef PROBE_REP
#define PROBE_REP 0
#endif
#define REP(k) ((((PROBE_REP) >> (k)) & 1) ? 2 : 1)
#define REPBAR() do { if (r_ > 0) { const int l2_ = opaque_lane(); xcd_barrier(bar, wid * 64 + l2_); } } while (0)
#define SEAM(k) do { if (IN(k) && IN((k) + 1)) { GET_TID; xcd_barrier(bar, tid); } } while (0)

#define x_in     (args.in[0])
#define c_in     (args.in[1])
#define g_norm1  (args.in[2])
#define g_norm2  (args.in[3])
#define w_ada    (args.in[4])
#define b_ada    (args.in[5])
#define fa_w_in  (args.in[6])
#define fa_w_out (args.in[7])
#define sg_w_in  (args.in[8])
#define sg_b_in  (args.in[9])
#define sg_g_v   (args.in[10])
#define sg_w_s   (args.in[11])
#define sg_b_s   (args.in[12])
#define sg_w_out (args.in[13])
#define w_group  (args.in[14])
#define b_group  (args.in[15])
#define w_router (args.in[16])
#define b_router (args.in[17])
#define w_gate   (args.in[18])
#define w_up     (args.in[19])
#define w_down   (args.in[20])
#define g_final  (args.in[21])
#define mod    ((float*)(args.ws + WS_MOD))
#define Wfin   ((bf16_t*)(args.ws + WS_WFIN))
#define Wfout  ((bf16_t*)(args.ws + WS_WFOUT))
#define Wsgin  ((bf16_t*)(args.ws + WS_WSGIN))
#define Wsgout ((bf16_t*)(args.ws + WS_WSGOUT))
#define DFTC   ((bf16_t*)(args.ws + WS_DFTC))
#define DFTS   ((bf16_t*)(args.ws + WS_DFTS))
#define hA     ((bf16_t*)(args.ws + WS_HA))
#define zB     ((bf16_t*)(args.ws + WS_ZB))
#define T2     ((bf16_t*)(args.ws + WS_T2))
#define fB     ((bf16_t*)(args.ws + WS_FB))
#define ubuf   T2
#define vbuf   (T2 + (size_t)T * D)
#define xa     ((float*)(args.ws + WS_XA))
#define xb     ((float*)(args.ws + WS_XB))
#define act    ((bf16_t*)(args.ws + WS_ACT))
#define ybuf   ((bf16_t*)(args.ws + WS_YB))
#define vss    ((float*)(args.ws + WS_VSS))
#define lists  ((int*)(args.ws + WS_LISTS))
#define tokw   ((float*)(args.ws + WS_TOKW))
#define LANE_SETUP GET_TID; const GemmLane L = make_lane(tid); const int wr = L.wr, wc = L.wc, fr = L.fr, fq = L.fq; f32x4 acc[2][2][4][2]; (void)wr; (void)wc; (void)fr; (void)fq

    if (IN(0)) for (int r_ = 0; r_ < REP(0); ++r_) { REPBAR(); GET_TID;
        {
            LAS float* ca = (LAS float*)lds;
            for (int i = tid; i < NB * D; i += 512) { const float v = c_in[i]; ca[i] = v / (1.f + __expf(-v)); }
            __syncthreads();
            for (int slab = bx; slab < 256; slab += G) {
            const int col0 = slab * 96; const int l = col0 / (6 * D), j0 = col0 % (6 * D);
            const int sub = lane / 24, c4 = lane % 24; const bool act_lane = lane < 48;
            f32x4 a0 = {0, 0, 0, 0}, a1 = a0, a2 = a0, a3 = a0;
            if (act_lane) {
                const float* wp = w_ada + (size_t)l * D * 6 * D + j0 + 4 * c4;
#pragma unroll 8
                for (int it = 0; it < 128; ++it) {
                    const int k = 256 * wid + 2 * it + sub;
                    const f32x4 wv = *(const f32x4*)(wp + (size_t)k * 6 * D);
                    a0 += ca[k] * wv; a1 += ca[D + k] * wv; a2 += ca[2 * D + k] * wv; a3 += ca[3 * D + k] * wv;
                }
            }
            __syncthreads();
            LAS float* red = (LAS float*)(lds + 32768);
            if (act_lane) { LAS f32x4* r = (LAS f32x4*)(red + (wid * 48 + lane) * 16); r[0] = a0; r[1] = a1; r[2] = a2; r[3] = a3; }
            __syncthreads();
            if (tid < 384) {
                const int b = tid / 96, cc = tid % 96, c4i = cc >> 2, e = cc & 3; float s = 0.f;
#pragma unroll
                for (int w = 0; w < 8; ++w)
#pragma unroll
                    for (int sb = 0; sb < 2; ++sb) s += red[(w * 48 + sb * 24 + c4i) * 16 + b * 4 + e];
                mod[((size_t)l * NB + b) * 6 * D + j0 + cc] = s + b_ada[l * 6 * D + j0 + cc];
            }
            __syncthreads();
            }
        }
        {
            const size_t gtid = (size_t)vcu * 512 + tid, gstride = (size_t)G * 512;
            auto conv = [&](const float* src, bf16_t* dst, size_t n8) {
                for (size_t i = gtid; i < n8; i += gstride) { const f32x4 a = *(const f32x4*)(src + i * 8), b = *(const f32x4*)(src + i * 8 + 4);
                    u32x4 w; w.x = cvt_pk(a[0], a[1]); w.y = cvt_pk(a[2], a[3]); w.z = cvt_pk(b[0], b[1]); w.w = cvt_pk(b[2], b[3]); *(u32x4*)(dst + i * 8) = w; } };
            conv(fa_w_in, Wfin, (size_t)D * D / 8); conv(fa_w_out, Wfout, (size_t)D * D / 8);
            conv(sg_w_in, Wsgin, (size_t)D * 2 * D / 8); conv(sg_w_out, Wsgout, (size_t)D * D / 8);
            for (size_t i = gtid; i < (size_t)CG * 1024 / 8; i += gstride) {
                const int n2 = (int)(i / 128), j0 = (int)(i % 128) * 8; float v[8];
#pragma unroll
                for (int e = 0; e < 8; ++e) { const int j = j0 + e, k2 = j & 511; const float ang = (float)((k2 * n2) & 511) * (2.0f / 512.0f); v[e] = (j < 512 ? cospif(ang) : sinpif(ang)) * (1.0f / 32.0f); }
                u32x4 w; w.x = cvt_pk(v[0], v[1]); w.y = cvt_pk(v[2], v[3]); w.z = cvt_pk(v[4], v[5]); w.w = cvt_pk(v[6], v[7]); *(u32x4*)(DFTC + i * 8) = w;
            }
            for (size_t i = gtid; i < (size_t)S * 4096 / 8; i += gstride) {
                const int k1 = (int)(i / 512), kk0 = (int)(i % 512) * 8; float v[8];
#pragma unroll
                for (int e = 0; e < 8; ++e) { const int kk = kk0 + e, n1 = kk & 2047; const float ang = (float)((k1 * n1) & 2047) * (2.0f / 2048.0f); v[e] = (kk < 2048 ? cospif(ang) : -sinpif(ang)) * (1.0f / 32.0f); }
                u32x4 w; w.x = cvt_pk(v[0], v[1]); w.y = cvt_pk(v[2], v[3]); w.z = cvt_pk(v[4], v[5]); w.w = cvt_pk(v[6], v[7]); *(u32x4*)(DFTS + i * 8) = w;
            }
        }
    }
    SEAM(0);

    if (IN(1)) for (int r_ = 0; r_ < REP(1); ++r_) { REPBAR(); GET_TID;
        for (int t = vcu * 8 + wid; t < T; t += G * 8) {
            const int b = t / S; const float* m = mod + (size_t)b * 6 * D;
            norm_token(lane, x_in + (size_t)t * D, nullptr, nullptr, nullptr, nullptr, g_norm1, m, m + D, hA + (size_t)t * D, nullptr);
        }
    }
    SEAM(1);

#define DENSE_UNIT(Aptr, lda, Bptr, ldb, Kdim) do { \
        unsigned _vo[2][2]; _Pragma("unroll") for (int _h = 0; _h < 2; ++_h) _Pragma("unroll") for (int _i = 0; _i < 2; ++_i) _vo[_h][_i] = (unsigned)(((_h * 128 + L.Ra[_i]) * (lda) + L.Ca[_i]) * 2); \
        gemm_unit<0, 2>(lds, L, (const char*)(Aptr), _vo, (const char*)(Bptr), nullptr, (unsigned)((ldb) * 2), (Kdim) / 64, acc); } while (0)

    if (IN(2)) for (int r_ = 0; r_ < REP(2); ++r_) { REPBAR(); LANE_SETUP;
        for (int u = vcu; u < 32 * 8; u += G) {
            const int pm = u >> 3, pn = u & 7;
            DENSE_UNIT(hA + (size_t)pm * 256 * D, D, Wfin + pn * 256, D, D);
#pragma unroll
            for (int ai = 0; ai < 2; ++ai)
#pragma unroll
                for (int m = 0; m < 4; ++m) { const int row = pm * 256 + ai * 128 + wr * 64 + m * 16 + fr;
#pragma unroll
                    for (int bj = 0; bj < 2; ++bj)
#pragma unroll
                        for (int n = 0; n < 2; ++n) { const int col = pn * 256 + bj * 128 + wc * 32 + n * 16 + 4 * fq; const f32x4 v = acc[ai][bj][m][n];
                            u32x2 w; w.x = cvt_pk(v[0], v[1]); w.y = cvt_pk(v[2], v[3]); *(u32x2*)(zB + (size_t)row * D + col) = w; } }
        }
    }
    SEAM(2);

    if (IN(3)) for (int r_ = 0; r_ < REP(3); ++r_) { REPBAR(); LANE_SETUP;
        for (int u = vcu; u < 32 * 16; u += G) {
            const int pm = u >> 4, pn = u & 15, g = pn >> 2, ct = pn & 3;
            DENSE_UNIT(zB + (size_t)pm * 256 * D + g * CG, D, DFTC + ct * 256, 1024, CG);
            const int which = ct >> 1; const int cbase = g * CG + (ct & 1) * 256;
#pragma unroll
            for (int ai = 0; ai < 2; ++ai)
#pragma unroll
                for (int m = 0; m < 4; ++m) { const int row = pm * 256 + ai * 128 + wr * 64 + m * 16 + fr; const int b = row >> 11, n1 = row & 2047;
                    bf16_t* orow = T2 + ((size_t)(b * 2 + which) * S + n1) * D + cbase;
#pragma unroll
                    for (int bj = 0; bj < 2; ++bj)
#pragma unroll
                        for (int n = 0; n < 2; ++n) { const int col = bj * 128 + wc * 32 + n * 16 + 4 * fq; const f32x4 v = acc[ai][bj][m][n];
                            u32x2 w; w.x = cvt_pk(v[0], v[1]); w.y = cvt_pk(v[2], v[3]); *(u32x2*)(orow + col) = w; } }
        }
    }
    SEAM(3);

    if (IN(4)) for (int r_ = 0; r_ < REP(4); ++r_) { REPBAR(); LANE_SETUP;
        for (int u = vcu; u < 32 * 8; u += G) {
            const int pm = u >> 3, pn = u & 7, b = pm >> 3, pk = pm & 7;
            DENSE_UNIT(DFTS + (size_t)pk * 256 * 4096, 4096, T2 + (size_t)b * 2 * S * D + pn * 256, D, 4096);
#pragma unroll
            for (int ai = 0; ai < 2; ++ai)
#pragma unroll
                for (int m = 0; m < 4; ++m) { const int row = pm * 256 + ai * 128 + wr * 64 + m * 16 + fr;
#pragma unroll
                    for (int bj = 0; bj < 2; ++bj)
#pragma unroll
                        for (int n = 0; n < 2; ++n) { const int col = pn * 256 + bj * 128 + wc * 32 + n * 16 + 4 * fq; const f32x4 v = acc[ai][bj][m][n];
                            u32x2 w; w.x = cvt_pk(v[0], v[1]); w.y = cvt_pk(v[2], v[3]); *(u32x2*)(fB + (size_t)row * D + col) = w; } }
        }
    }
    SEAM(4);

#define RESID_EPI(basep, gatep, dstp) do { \
        _Pragma("unroll") for (int ai = 0; ai < 2; ++ai) _Pragma("unroll") for (int m = 0; m < 4; ++m) { const int row = pm * 256 + ai * 128 + wr * 64 + m * 16 + fr; const int b = row >> 11; \
            _Pragma("unroll") for (int bj = 0; bj < 2; ++bj) _Pragma("unroll") for (int n = 0; n < 2; ++n) { const int col = pn * 256 + bj * 128 + wc * 32 + n * 16 + 4 * fq; \
                const f32x4 gt = *(const f32x4*)((gatep) + (size_t)b * 6 * D + col); const f32x4 bs = *(const f32x4*)((basep) + (size_t)row * D + col); \
                *(f32x4*)((dstp) + (size_t)row * D + col) = bs + gt * acc[ai][bj][m][n]; } } } while (0)

    if (IN(5)) for (int r_ = 0; r_ < REP(5); ++r_) { REPBAR(); LANE_SETUP;
        for (int u = vcu; u < 32 * 8; u += G) {
            const int pm = u >> 3, pn = u & 7;
            DENSE_UNIT(fB + (size_t)pm * 256 * D, D, Wfout + pn * 256, D, D);
            RESID_EPI(x_in, mod + 2 * D, xa);
        }
    }
    SEAM(5);

    auto route_phase = [&](int l, const float* xsrc) { GET_TID;
        const float* g2 = g_norm2 + l * D; const float* m_l = mod + (size_t)l * NB * 6 * D;
        const float* wg = w_group + (size_t)l * D * NG; const float* wrt = w_router + (size_t)l * D * NE;
        const float* bg = b_group + l * NG; const float* brt = b_router + l * NE;
        unsigned* counts = ctl + CW_COUNTS + l * 32; int* lst = lists + (size_t)l * NE * T; float* tw = tokw + (size_t)l * T * 2;
        LAS float* wl = (LAS float*)lds;
        LAS float* lg4 = (LAS float*)(lds + 40960);
        LAS int* sel = (LAS int*)(lds + 40960 + 18432);
        LAS int* rnk = sel + 64;
        LAS int* hist = rnk + 64;
        LAS int* gbase = hist + 32;
#pragma unroll 1
        for (int tb = vcu * 32; tb < T; tb += G * 32) {
            const int b = tb / S; const int tk0 = tb + wid * 4;
            const float* scp = m_l + (size_t)b * 6 * D + 4 * D; const float* shp = m_l + (size_t)b * 6 * D + 3 * D;
            float rstd[4];
#pragma unroll
            for (int k = 0; k < 4; ++k) { const float* xr = xsrc + (size_t)(tk0 + k) * D; float ss = 0.f;
#pragma unroll 8
                for (int i = 0; i < 32; ++i) { const float v = xr[64 * i + lane]; ss += v * v; }
                rstd[k] = rsqrtf(wave_sum(ss) * (1.f / D) + EPS); }
            f32x2 a2[4][18];
#pragma unroll
            for (int k = 0; k < 4; ++k)
#pragma unroll
                for (int o = 0; o < 18; ++o) a2[k][o] = (f32x2){0.f, 0.f};
            if (tid < 32) hist[tid] = 0;
#pragma unroll 1
            for (int j = 0; j < 8; ++j) {
                __syncthreads();
                for (int i = tid; i < 256 * 8; i += 512) { const int ch = i >> 3, c4 = i & 7; const f32x4 v = *(const f32x4*)(wrt + (size_t)(256 * j + ch) * NE + 4 * c4); *(LAS f32x4*)(wl + ch * 36 + 4 + 4 * c4) = v; }
                if (tid < 256) { const f32x4 v = *(const f32x4*)(wg + (size_t)(256 * j + tid) * NG); *(LAS f32x4*)(wl + tid * 36) = v; }
                __syncthreads();
#pragma unroll 1
                for (int cc = 0; cc < 4; ++cc) {
                    const int d = 256 * j + 64 * cc + lane;
                    const float gsc = g2[d] * (1.f + scp[d]), shv = shp[d];
                    f32x2 h2[4];
#pragma unroll
                    for (int k = 0; k < 4; ++k) { const float hh = xsrc[(size_t)(tk0 + k) * D + d] * rstd[k] * gsc + shv; h2[k] = (f32x2){hh, hh};
                        hA[(size_t)(tk0 + k) * D + d] = (bf16_t)(cvt_pk(hh, 0.f) & 0xffffu); }
                    const LAS f32x4* wrow = (const LAS f32x4*)(wl + (cc * 64 + lane) * 36);
#pragma unroll
                    for (int q = 0; q < 9; ++q) { const f32x4 wv = wrow[q]; const f32x2 w01 = (f32x2){wv[0], wv[1]}, w23 = (f32x2){wv[2], wv[3]};
#pragma unroll
                        for (int k = 0; k < 4; ++k) { a2[k][2 * q] += h2[k] * w01; a2[k][2 * q + 1] += h2[k] * w23; } }
                }
            }
#pragma unroll
            for (int k = 0; k < 4; ++k)
#pragma unroll
                for (int o = 0; o < 36; ++o) { const float r = row_sum16(a2[k][o >> 1][o & 1]); if ((lane & 15) == 0) lg4[((wid * 4 + k) * 36 + o) * 4 + (lane >> 4)] = r; }
            __syncthreads();
            if (tid < 32) {
                const LAS f32x4* lp = (const LAS f32x4*)(lg4 + tid * 36 * 4);
                float gl[4];
#pragma unroll
                for (int i = 0; i < 4; ++i) { const f32x4 v = lp[i]; gl[i] = ((v[0] + v[1]) + (v[2] + v[3])) + bg[i]; }
                int gi = 0; float gm = gl[0];
#pragma unroll
                for (int i = 1; i < 4; ++i) if (gl[i] > gm) { gm = gl[i]; gi = i; }
                float se = 0.f;
#pragma unroll
                for (int i = 0; i < 4; ++i) se += __expf(gl[i] - gm);
                const float gw = 1.f / se;
                float el[8];
#pragma unroll
                for (int i = 0; i < 8; ++i) { const f32x4 v = lp[4 + gi * 8 + i]; el[i] = ((v[0] + v[1]) + (v[2] + v[3])) + brt[gi * 8 + i]; }
                int i0 = 0; float v0 = el[0];
#pragma unroll
                for (int i = 1; i < 8; ++i) if (el[i] > v0) { v0 = el[i]; i0 = i; }
                int i1 = 0; float v1 = -3.4e38f;
#pragma unroll
                for (int i = 0; i < 8; ++i) if (i != i0 && el[i] > v1) { v1 = el[i]; i1 = i; }
                const float e1 = __expf(v1 - v0); const float p0 = 1.f / (1.f + e1), p1 = e1 / (1.f + e1);
                const int tk = tb + tid; const int ex0 = gi * EPG + i0, ex1 = gi * EPG + i1;
                tw[tk * 2 + 0] = p0 * gw; tw[tk * 2 + 1] = p1 * gw;
                sel[tid * 2] = ex0; sel[tid * 2 + 1] = ex1;
                rnk[tid * 2] = atomicAdd((int*)&hist[ex0], 1); rnk[tid * 2 + 1] = atomicAdd((int*)&hist[ex1], 1);
            }
            __syncthreads();
            if (tid < 32) { const int c = hist[tid]; gbase[tid] = c > 0 ? (int)atomicAdd(&counts[tid], (unsigned)c) : 0; }
            __syncthreads();
            if (tid < 64) { const int e = sel[tid]; lst[(size_t)e * T + gbase[e] + rnk[tid]] = (tb + (tid >> 1)) * 2 + (tid & 1); }
            __syncthreads();
        }
    };

    auto moe1_phase = [&](int l) { LANE_SETUP;
        const unsigned* counts = ctl + CW_COUNTS + l * 32; const int* lst = lists + (size_t)l * NE * T;
        const float* WG = w_gate + (size_t)l * NE * D * DE; const float* WU = w_up + (size_t)l * NE * D * DE;
        int ustart = 0, base = 0;
#pragma unroll 1
        for (int e = 0; e < NE; ++e) {
            const int cnt = (int)counts[e]; const int nrt = (cnt + 255) >> 8; const int nun = nrt * 4;
            int first = vcu - (ustart % G); if (first < 0) first += G;
#pragma unroll 1
            for (int r = first; r < nun; r += G) {
                const int ct = r / nrt, rt = r % nrt;
                unsigned vo[2][2];
#pragma unroll
                for (int hh = 0; hh < 2; ++hh)
#pragma unroll
                    for (int i = 0; i < 2; ++i) { const int mrow = rt * 256 + hh * 128 + L.Ra[i]; const int ent = (mrow < cnt) ? lst[(size_t)e * T + mrow] : 0; vo[hh][i] = (unsigned)(((ent >> 1) * D + L.Ca[i]) * 2); }
                const float* wgp = WG + (size_t)e * D * DE + ct * 128; const float* wup = WU + (size_t)e * D * DE + ct * 128;
                gemm_unit<1, 2>(lds, L, (const char*)hA, vo, (const char*)wgp, (const char*)wup, (unsigned)(DE * 4), D / 64, acc);
#pragma unroll
                for (int ai = 0; ai < 2; ++ai)
#pragma unroll
                    for (int m = 0; m < 4; ++m) { const int mrow = rt * 256 + ai * 128 + wr * 64 + m * 16 + fr;
                        if (mrow < cnt) { bf16_t* orow = act + (size_t)(base + mrow) * DE + ct * 128;
#pragma unroll
                            for (int n = 0; n < 2; ++n) { const f32x4 gv = acc[ai][0][m][n], uv = acc[ai][1][m][n];
                                u32x2 w; w.x = cvt_pk(silu_f(gv[0]) * uv[0], silu_f(gv[1]) * uv[1]); w.y = cvt_pk(silu_f(gv[2]) * uv[2], silu_f(gv[3]) * uv[3]);
                                *(u32x2*)(orow + wc * 32 + n * 16 + 4 * fq) = w; } }
                        asm volatile("" ::: "memory"); }
            }
            ustart += nun; base += cnt;
        }
    };
    auto moe2_phase = [&](int l) { LANE_SETUP;
        const unsigned* counts = ctl + CW_COUNTS + l * 32; const int* lst = lists + (size_t)l * NE * T; const float* tw = tokw + (size_t)l * T * 2;
        const float* WD = w_down + (size_t)l * NE * DE * D;
        int ustart = 0, base = 0;
#pragma unroll 1
        for (int e = 0; e < NE; ++e) {
            const int cnt = (int)counts[e]; const int nrt = (cnt + 255) >> 8; const int nun = nrt * 8;
            int first = vcu - (ustart % G); if (first < 0) first += G;
#pragma unroll 1
            for (int r = first; r < nun; r += G) {
                const int ct = r / nrt, rt = r % nrt;
                unsigned vo[2][2];
#pragma unroll
                for (int hh = 0; hh < 2; ++hh)
#pragma unroll
                    for (int i = 0; i < 2; ++i) vo[hh][i] = (unsigned)(((hh * 128 + L.Ra[i]) * DE + L.Ca[i]) * 2);
                const float* wdp = WD + (size_t)e * DE * D + ct * 256;
                gemm_unit<1, 2>(lds, L, (const char*)(act + (size_t)(base + rt * 256) * DE), vo, (const char*)wdp, (const char*)(wdp + 128), (unsigned)(D * 4), DE / 64, acc);
#pragma unroll
                for (int ai = 0; ai < 2; ++ai)
#pragma unroll
                    for (int m = 0; m < 4; ++m) { const int mrow = rt * 256 + ai * 128 + wr * 64 + m * 16 + fr;
                        if (mrow < cnt) { const int ent = lst[(size_t)e * T + mrow]; const float w8 = tw[ent]; bf16_t* orow = ybuf + (size_t)ent * D + ct * 256;
#pragma unroll
                            for (int bj = 0; bj < 2; ++bj)
#pragma unroll
                                for (int n = 0; n < 2; ++n) { const f32x4 v = acc[ai][bj][m][n] * w8;
                                    u32x2 w; w.x = cvt_pk(v[0], v[1]); w.y = cvt_pk(v[2], v[3]); *(u32x2*)(orow + bj * 128 + wc * 32 + n * 16 + 4 * fq) = w; } }
                        asm volatile("" ::: "memory"); }
            }
            ustart += nun; base += cnt;
        }
    };

    if (IN(6)) route_phase(0, xa);
    SEAM(6);
    if (IN(7)) for (int r_ = 0; r_ < REP(7); ++r_) { REPBAR(); moe1_phase(0); }
    SEAM(7);
    if (IN(8)) for (int r_ = 0; r_ < REP(8); ++r_) { REPBAR(); moe2_phase(0); }
    SEAM(8);

    if (IN(9)) for (int r_ = 0; r_ < REP(9); ++r_) { REPBAR(); GET_TID;
        const float* m1 = mod + (size_t)NB * 6 * D;
        for (int t = vcu * 8 + wid; t < T; t += G * 8) {
            const int b = t / S;
            norm_token(lane, xa + (size_t)t * D, ybuf + (size_t)t * 2 * D, ybuf + (size_t)t * 2 * D + D, mod + (size_t)b * 6 * D + 5 * D, xb + (size_t)t * D,
                       g_norm1 + D, m1 + (size_t)b * 6 * D, m1 + (size_t)b * 6 * D + D, hA + (size_t)t * D, nullptr);
        }
    }
    SEAM(9);

    if (IN(10)) for (int r_ = 0; r_ < REP(10); ++r_) { REPBAR(); LANE_SETUP;
        for (int u = vcu; u < 32 * 16; u += G) {
            const int pm = u >> 4, pn = u & 15;
            DENSE_UNIT(hA + (size_t)pm * 256 * D, D, Wsgin + pn * 256, 2 * D, D);
            const bool isv = pn >= 8; bf16_t* dst = isv ? vbuf : ubuf; const int cb = (pn & 7) * 256;
#pragma unroll
            for (int ai = 0; ai < 2; ++ai)
#pragma unroll
                for (int m = 0; m < 4; ++m) { const int row = pm * 256 + ai * 128 + wr * 64 + m * 16 + fr; float ss = 0.f;
#pragma unroll
                    for (int bj = 0; bj < 2; ++bj)
#pragma unroll
                        for (int n = 0; n < 2; ++n) { const int cl = bj * 128 + wc * 32 + n * 16 + 4 * fq; const f32x4 bi = *(const f32x4*)(sg_b_in + pn * 256 + cl); f32x4 v = acc[ai][bj][m][n] + bi;
                            v[0] = gelu_tanh(v[0]); v[1] = gelu_tanh(v[1]); v[2] = gelu_tanh(v[2]); v[3] = gelu_tanh(v[3]);
                            ss += (v[0] * v[0] + v[1] * v[1]) + (v[2] * v[2] + v[3] * v[3]);
                            u32x2 w; w.x = cvt_pk(v[0], v[1]); w.y = cvt_pk(v[2], v[3]); *(u32x2*)(dst + (size_t)row * D + cb + cl) = w; }
                    if (isv) { ss += __shfl_xor(ss, 16); ss += __shfl_xor(ss, 32); if (fq == 0) vss[(size_t)row * 32 + (pn - 8) * 4 + wc] = ss; } }
        }
    }
    SEAM(10);

    if (IN(11)) for (int r_ = 0; r_ < REP(11); ++r_) { REPBAR(); LANE_SETUP;
        LAS float* rs = (LAS float*)(lds + MISC_OFF + 1024);
        for (int u = vcu; u < 64 * 8; u += G) {
            const int ch = u >> 3, hd = u & 7;
            WAIT_V(0); WAIT_L0(); __syncthreads();
            if (tid < 128) { const f32x4* p = (const f32x4*)(vss + (size_t)(ch * CH + tid) * 32); float s = 0.f;
#pragma unroll
                for (int i = 0; i < 8; ++i) { const f32x4 v = p[i]; s += (v[0] + v[1]) + (v[2] + v[3]); }
                rs[tid] = rsqrtf(s * (1.f / D) + EPS); }
            __syncthreads();
#pragma unroll
            for (int i = 0; i < 4; ++i) { const int idx = tid + i * 512; const int p = idx >> 4, q8 = idx & 15;
                const f32x4 a = *(const f32x4*)(sg_w_s + ((size_t)hd * CH + p) * CH + q8 * 8), b2 = *(const f32x4*)(sg_w_s + ((size_t)hd * CH + p) * CH + q8 * 8 + 4);
                const f32x4 r0 = *(const LAS f32x4*)(rs + q8 * 8), r1 = *(const LAS f32x4*)(rs + q8 * 8 + 4);
                u32x4 w; w.x = cvt_pk(a[0] * r0[0], a[1] * r0[1]); w.y = cvt_pk(a[2] * r0[2], a[3] * r0[3]); w.z = cvt_pk(b2[0] * r1[0], b2[1] * r1[1]); w.w = cvt_pk(b2[2] * r1[2], b2[3] * r1[3]);
                *(LAS u32x4*)(lds + SA_OFF(q8 >> 3, 0) + lds_byte(p, (q8 & 7) * 8)) = w; }
            { const char* Bb = (const char*)(vbuf + (size_t)ch * CH * D + hd * DH);
#pragma unroll
              for (int kt = 0; kt < 2; ++kt)
#pragma unroll
                for (int hh = 0; hh < 2; ++hh)
#pragma unroll
                    for (int i = 0; i < 2; ++i)
                        __builtin_amdgcn_global_load_lds((const unsigned*)(Bb + (size_t)(kt * 64 + L.Rb[i]) * (D * 2) + hh * 256 + L.Cb16[i] * 16), (LAS unsigned*)(lds + SB_OFF(kt, hh) + wid * 1024 + i * 8192), 16, 0, 0); }
            WAIT_V(0); WAIT_L0(); __syncthreads();
            f32x4 ac[2][4][2];
#pragma unroll
            for (int bj = 0; bj < 2; ++bj)
#pragma unroll
                for (int m = 0; m < 4; ++m)
#pragma unroll
                    for (int n = 0; n < 2; ++n) ac[bj][m][n] = (f32x4){0.f, 0.f, 0.f, 0.f};
#pragma unroll
            for (int kt = 0; kt < 2; ++kt) {
                bf16x8 At[4][2];
#pragma unroll
                for (int m = 0; m < 4; ++m)
#pragma unroll
                    for (int k = 0; k < 2; ++k) At[m][k] = *(const LAS bf16x8*)(lds + SA_OFF(kt, 0) + L.aoff + m * 2048 + k * 1024);
#pragma unroll
                for (int bj = 0; bj < 2; ++bj)
#pragma unroll
                    for (int n = 0; n < 2; ++n)
#pragma unroll
                        for (int k = 0; k < 2; ++k) {
                            const s16x4 lo4 = __builtin_amdgcn_ds_read_tr16_b64_v4i16((LAS s16x4*)(lds + SB_OFF(kt, bj) + L.boff[n] + k * 8192));
                            const s16x4 hi4 = __builtin_amdgcn_ds_read_tr16_b64_v4i16((LAS s16x4*)(lds + SB_OFF(kt, bj) + L.boff[n] + k * 8192 + 1024));
                            const bf16x8 bfrag = __builtin_shufflevector(lo4, hi4, 0, 1, 2, 3, 4, 5, 6, 7);
#pragma unroll
                            for (int m = 0; m < 4; ++m) ac[bj][m][n] = __builtin_amdgcn_mfma_f32_16x16x32_bf16(bfrag, At[m][k], ac[bj][m][n], 0, 0, 0);
                        }
            }
#pragma unroll
            for (int m = 0; m < 4; ++m) { const int p = wr * 64 + m * 16 + fr; const size_t tok = (size_t)ch * CH + p; const float bs = sg_b_s[hd * CH + p];
#pragma unroll
                for (int bj = 0; bj < 2; ++bj)
#pragma unroll
                    for (int n = 0; n < 2; ++n) { const int d = hd * DH + bj * 128 + wc * 32 + n * 16 + 4 * fq; const f32x4 gv = *(const f32x4*)(sg_g_v + d); const u32x2 uu = *(const u32x2*)(ubuf + tok * D + d);
                        const f32x4 mx = gv * ac[bj][m][n] + bs;
                        u32x2 w; w.x = cvt_pk(bf_lo(uu.x) * mx[0], bf_hi(uu.x) * mx[1]); w.y = cvt_pk(bf_lo(uu.y) * mx[2], bf_hi(uu.y) * mx[3]); *(u32x2*)(zB + tok * D + d) = w; } }
        }
        WAIT_V(0); WAIT_L0(); __syncthreads();
    }
    SEAM(11);

    if (IN(12)) for (int r_ = 0; r_ < REP(12); ++r_) { REPBAR(); LANE_SETUP;
        for (int u = vcu; u < 32 * 8; u += G) {
            const int pm = u >> 3, pn = u & 7;
            DENSE_UNIT(zB + (size_t)pm * 256 * D, D, Wsgout + pn * 256, D, D);
            RESID_EPI(xb, mod + (size_t)NB * 6 * D + 2 * D, xa);
        }
    }
    SEAM(12);

    if (IN(13)) route_phase(1, xa);
    SEAM(13);
    if (IN(14)) for (int r_ = 0; r_ < REP(14); ++r_) { REPBAR(); moe1_phase(1); }
    SEAM(14);
    if (IN(15)) for (int r_ = 0; r_ < REP(15); ++r_) { REPBAR(); moe2_phase(1); }
    SEAM(15);

    if (IN(16)) for (int r_ = 0; r_ < REP(16); ++r_) { REPBAR(); GET_TID;
        const float* m1 = mod + (size_t)NB * 6 * D;
        for (int t = vcu * 8 + wid; t < T; t += G * 8) {
            const int b = t / S;
            norm_token(lane, xa + (size_t)t * D, ybuf + (size_t)t * 2 * D, ybuf + (size_t)t * 2 * D + D, m1 + (size_t)b * 6 * D + 5 * D, nullptr,
                       g_final, nullptr, nullptr, nullptr, args.out + (size_t)t * D);
        }
    }
#undef IN
#undef SEAM
}
}

extern "C" void kernel_launch(void* const* d_in, const int* in_sizes, int n_in, void* d_out, int out_size, void* d_ws, size_t ws_size, hipStream_t stream) {
    using namespace mk;
    static int grid = 0;
    if (grid == 0) {
        if (n_in != 22 || ws_size < WS_END) { fprintf(stderr, "kernel_launch: unexpected inputs (n_in %d, ws %zu)\n", n_in, ws_size); grid = -1; return; }
        int dev = 0, cus = 0, per_cu = 0;
        hipGetDevice(&dev); hipDeviceGetAttribute(&cus, hipDeviceAttributeMultiprocessorCount, dev);
        if (hipFuncSetAttribute((const void*)mk_fwd, hipFuncAttributeMaxDynamicSharedMemorySize, LDS_BYTES) != hipSuccess) { fprintf(stderr, "kernel_launch: hipFuncSetAttribute failed\n"); grid = -1; return; }
        if (hipOccupancyMaxActiveBlocksPerMultiprocessor(&per_cu, (const void*)mk_fwd, 512, LDS_BYTES) != hipSuccess || per_cu < 1) fprintf(stderr, "kernel_launch: occupancy query says %d\n", per_cu);
        (void)hipGetLastError();
        grid = cus;
    }
    if (grid < 0) return;
    hipMemsetAsync((char*)d_ws + WS_CTL, 0, CTL_BYTES, stream);
    Args a{};
    for (int i = 0; i < 22; ++i) a.in[i] = (const float*)d_in[i];
    a.out = (float*)d_out; a.ws = (unsigned char*)d_ws;
#if MK_MULTI
    for (int p = 0; p < NPH; ++p) { a.ph_lo = p; a.ph_hi = p + 1; hipLaunchKernelGGL(mk_fwd, dim3(grid), dim3(512), LDS_BYTES, stream, a); }
#else
    a.ph_lo = 0; a.ph_hi = NPH;
    hipLaunchKernelGGL(mk_fwd, dim3(grid), dim3(512), LDS_BYTES, stream, a);
#endif
}
```

```cpp
#include <hip/hip_runtime.h>
#include <stdint.h>
#include <cstdio>

#ifndef MK_MULTI
#define MK_MULTI 0
#endif

namespace mk {
#define LAS __attribute__((address_space(3)))
typedef unsigned short bf16_t;
typedef short bf16x8 __attribute__((ext_vector_type(8)));
typedef short s16x4 __attribute__((ext_vector_type(4)));
typedef float f32x4 __attribute__((ext_vector_type(4)));
typedef float f32x2 __attribute__((ext_vector_type(2)));
typedef unsigned u32x2 __attribute__((ext_vector_type(2)));
typedef unsigned u32x4 __attribute__((ext_vector_type(4)));

constexpr int D = 2048, NB = 4, S = 2048, T = NB * S;
constexpr int CG = 512;
constexpr int HEADS = 8, CH = 128, DH = 256;
constexpr int NG = 4, EPG = 8, NE = 32, DE = 512;
constexpr float EPS = 1e-6f;
constexpr int NPH = 17;

constexpr size_t MiB = 1u << 20;
constexpr size_t WS_CTL = 0, CTL_BYTES = 1 * MiB;
constexpr size_t WS_MOD = 1 * MiB;
constexpr size_t WS_WFIN = 2 * MiB;
constexpr size_t WS_WFOUT = 10 * MiB;
constexpr size_t WS_WSGIN = 18 * MiB;
constexpr size_t WS_WSGOUT = 34 * MiB;
constexpr size_t WS_DFTC = 42 * MiB;
constexpr size_t WS_DFTS = 44 * MiB;
constexpr size_t WS_HA = 60 * MiB;
constexpr size_t WS_ZB = 92 * MiB;
constexpr size_t WS_T2 = 124 * MiB;
constexpr size_t WS_FB = 188 * MiB;
constexpr size_t WS_XA = 220 * MiB;
constexpr size_t WS_XB = 284 * MiB;
constexpr size_t WS_ACT = 348 * MiB;
constexpr size_t WS_YB = 366 * MiB;
constexpr size_t WS_VSS = 430 * MiB;
constexpr size_t WS_LISTS = 432 * MiB;
constexpr size_t WS_TOKW = 435 * MiB;
constexpr size_t WS_END = 436 * MiB;
constexpr int CW_COUNTS = 64;
constexpr int CW_BAR = 4096;

constexpr int HTB = 16384;
constexpr int RING_BYTES = 131072;
constexpr int MISC_OFF = RING_BYTES;
constexpr int LDS_BYTES = 147456;
#define SA_OFF(b, h) (((b) * 2 + (h)) * HTB)
#define SB_OFF(b, h) ((4 + (b) * 2 + (h)) * HTB)

#define XB_TMO      128
#define XB_XCNT(j)  (256  + 64 * (j))
#define XB_XSUB(j)  (1280 + 64 * (j))
#define XB_XGEN(j)  (2304 + 64 * (j))
#define XB_TOP      3328
#define XB_TOPGEN   3392
#define XCD_BAR_WORDS 3456
#define XB_SPIN_CAP (1u << 18)
__device__ __forceinline__ unsigned xb_ld(unsigned* p)              { return __hip_atomic_load(p, __ATOMIC_RELAXED, __HIP_MEMORY_SCOPE_AGENT); }
__device__ __forceinline__ unsigned xb_add(unsigned* p, unsigned v) { return __hip_atomic_fetch_add(p, v, __ATOMIC_RELAXED, __HIP_MEMORY_SCOPE_AGENT); }
__device__ __forceinline__ unsigned xb_xcc_id() { return (unsigned)__builtin_amdgcn_s_getreg((3 << 11) | 20) & 0xFu; }
#define XB_SPIN(cond, bar) do { unsigned _sp = 0; while (cond) { __builtin_amdgcn_s_sleep(1); \
    if ((++_sp & 255u) == 0u) { if (xb_ld(&(bar)[XB_TMO])) break; if (_sp > XB_SPIN_CAP) { atomicAdd(&(bar)[XB_TMO], 1u); break; } } } } while (0)
struct XcdBarrier { unsigned* bar; unsigned x; volatile LAS unsigned* st; };
__device__ __forceinline__ XcdBarrier xcd_barrier_post(unsigned* bar, volatile LAS unsigned* st, int tid) {
    XcdBarrier b; b.bar = bar; b.x = xb_xcc_id(); b.st = st;
    if (tid == 0) (void)xb_add(&bar[XB_XCNT(b.x)], 1u);
    return b;
}
__device__ __forceinline__ void xcd_barrier_complete(unsigned* bar, unsigned x, unsigned& nloc, unsigned& nx) {
    const unsigned G = gridDim.x * gridDim.y * gridDim.z;
    unsigned sum, cnt, mine, sp = 0u;
    for (;;) {
        sum = 0u; cnt = 0u; mine = 0u;
#pragma unroll
        for (unsigned j = 0; j < 16; ++j) { const unsigned c = xb_ld(&bar[XB_XCNT(j)]); sum += c; cnt += (c > 0u) ? 1u : 0u; mine = (j == x) ? c : mine; }
        if (sum == G) break;
        __builtin_amdgcn_s_sleep(1);
        if ((++sp & 255u) == 0u) { if (xb_ld(&bar[XB_TMO])) break; if (sp > XB_SPIN_CAP) { atomicAdd(&bar[XB_TMO], 1u); break; } }
    }
    nloc = mine > 0u ? mine : 1u; nx = cnt > 0u ? cnt : 1u;
}
__device__ __forceinline__ void xcd_barrier(const XcdBarrier& b, int tid) {
    asm volatile("s_waitcnt vmcnt(0)" ::: "memory");
    __syncthreads();
    if (tid == 0) {
        unsigned* bar = b.bar;
        __builtin_amdgcn_s_waitcnt(0);
        unsigned nloc = b.st[0], nx = b.st[1];
        if (nloc == 0u) { xcd_barrier_complete(bar, b.x, nloc, nx); b.st[0] = nloc; b.st[1] = nx; }
        const unsigned old = xb_add(&bar[XB_XSUB(b.x)], 1u);
        const unsigned gen = old / nloc;
        if (old + 1u == (gen + 1u) * nloc) {
            __builtin_amdgcn_fence(__ATOMIC_RELEASE, "agent");
            asm volatile("s_waitcnt vmcnt(0)" ::: "memory");
            const unsigned og = xb_add(&bar[XB_TOP], 1u);
            const unsigned tg = og / nx;
            if (og + 1u == (tg + 1u) * nx) xb_add(&bar[XB_TOPGEN], 1u);
            else XB_SPIN(xb_ld(&bar[XB_TOPGEN]) == tg, bar);
            __builtin_amdgcn_fence(__ATOMIC_ACQUIRE, "agent");
            xb_add(&bar[XB_XGEN(b.x)], 1u);
            asm volatile("s_waitcnt vmcnt(0)" ::: "memory");
        } else {
            XB_SPIN(xb_ld(&bar[XB_XGEN(b.x)]) == gen, bar);
            __builtin_amdgcn_fence(__ATOMIC_ACQUIRE, "agent");
            asm volatile("s_waitcnt vmcnt(0)" ::: "memory");
        }
    }
    __syncthreads();
}

__device__ __forceinline__ unsigned cvt_pk(float lo, float hi) { unsigned r; asm("v_cvt_pk_bf16_f32 %0, %1, %2" : "=v"(r) : "v"(lo), "v"(hi)); return r; }
__device__ __forceinline__ float bf_lo(unsigned w) { return __uint_as_float(w << 16); }
__device__ __forceinline__ float bf_hi(unsigned w) { return __uint_as_float(w & 0xffff0000u); }
__device__ __forceinline__ float wave_sum(float v) {
#pragma unroll
    for (int o = 1; o < 64; o <<= 1) v += __shfl_xor(v, o);
    return v;
}
__device__ __forceinline__ int opaque_lane() { int l = (int)__builtin_amdgcn_mbcnt_hi(~0u, __builtin_amdgcn_mbcnt_lo(~0u, 0u)); asm volatile("" : "+v"(l)); return l; }
__device__ __forceinline__ float dpp_add(float v, float w) { return v + w; }
#define DPP_STEP(v, ctrl) v += __builtin_bit_cast(float, __builtin_amdgcn_update_dpp(0, __builtin_bit_cast(int, v), ctrl, 0xf, 0xf, true))
__device__ __forceinline__ float row_sum16(float v) { DPP_STEP(v, 0xB1); DPP_STEP(v, 0x4E); DPP_STEP(v, 0x141); DPP_STEP(v, 0x140); return v; }
#define WAIT_V(n) asm volatile("s_waitcnt vmcnt(" #n ")" ::: "memory")
#define WAIT_L0() asm volatile("s_waitcnt lgkmcnt(0)" ::: "memory")
#define BAR() __builtin_amdgcn_s_barrier()

__device__ __forceinline__ int lds_byte(int r, int c) { const int st = (r >> 4) * 2 + (c >> 5), rr = r & 15, cc = c & 31, ob = rr * 64 + cc * 2; return st * 1024 + (ob ^ (((ob >> 9) & 1) << 5)); }
__device__ __forceinline__ void stage_rc(int b, int& R, int& C) { const int st = b / 1024, sb = b % 1024, swz = sb ^ (((sb >> 9) & 1) << 5); R = (st >> 1) * 16 + swz / 64; C = (st & 1) * 32 + (swz % 64) / 2; }
__device__ __forceinline__ int brow_f(int row) { return (row & 3) | (((row >> 3) & 1) << 2); }

__device__ __forceinline__ void ldb_tr(bf16x8 (&dst)[2][2], unsigned a0, unsigned a1) {
    s16x4 r0, r1, r2, r3, r4, r5, r6, r7;
    asm volatile("ds_read_b64_tr_b16 %0, %8\n\t"
                 "ds_read_b64_tr_b16 %1, %8 offset:1024\n\t"
                 "ds_read_b64_tr_b16 %2, %8 offset:8192\n\t"
                 "ds_read_b64_tr_b16 %3, %8 offset:9216\n\t"
                 "ds_read_b64_tr_b16 %4, %9\n\t"
                 "ds_read_b64_tr_b16 %5, %9 offset:1024\n\t"
                 "ds_read_b64_tr_b16 %6, %9 offset:8192\n\t"
                 "ds_read_b64_tr_b16 %7, %9 offset:9216\n\t"
                 "s_waitcnt lgkmcnt(0)"
                 : "=&v"(r0), "=&v"(r1), "=&v"(r2), "=&v"(r3), "=&v"(r4), "=&v"(r5), "=&v"(r6), "=&v"(r7)
                 : "v"(a0), "v"(a1) : "memory");
    dst[0][0] = __builtin_shufflevector(r0, r1, 0, 1, 2, 3, 4, 5, 6, 7); dst[0][1] = __builtin_shufflevector(r2, r3, 0, 1, 2, 3, 4, 5, 6, 7);
    dst[1][0] = __builtin_shufflevector(r4, r5, 0, 1, 2, 3, 4, 5, 6, 7); dst[1][1] = __builtin_shufflevector(r6, r7, 0, 1, 2, 3, 4, 5, 6, 7);
}

struct GemmLane {
    int wid, lane, wr, wc, fr, fq;
    int Ra[2], Ca[2];
    unsigned aoff;
    unsigned boff[2];
    int Rb[2], Cb16[2];
};
__device__ __forceinline__ GemmLane make_lane(int tid) {
    GemmLane L;
    L.wid = __builtin_amdgcn_readfirstlane(tid >> 6); L.lane = tid & 63; L.wr = L.wid >> 2; L.wc = L.wid & 3; L.fr = L.lane & 15; L.fq = L.lane >> 4;
#pragma unroll
    for (int i = 0; i < 2; ++i) {
        stage_rc(tid * 16 + i * 8192, L.Ra[i], L.Ca[i]);
        const int row = i * 32 + (tid >> 4); const int slot_phys = (tid & 15) >> 1; const int slot_log = slot_phys ^ brow_f(row);
        L.Rb[i] = row; L.Cb16[i] = slot_log * 2 + (tid & 1);
    }
    L.aoff = (unsigned)lds_byte(L.wr * 64 + L.fr, L.fq * 8);
    const int q = (L.lane & 15) >> 2, p = L.lane & 3, f = q | ((L.fq & 1) << 2);
#pragma unroll
    for (int n = 0; n < 2; ++n) L.boff[n] = (unsigned)((8 * L.fq + q) * 256 + 8 * p + (((L.wc * 2 + n) ^ f) * 32));
    return L;
}

template <int BMODE, int NAI>
__device__ __forceinline__ void gemm_unit(LAS unsigned char* lds, const GemmLane& L, const char* Ab, const unsigned (&voffA)[2][2],
                                          const char* B0, const char* B1, unsigned ldb_bytes, int nt, f32x4 (&acc)[2][2][4][2]) {
    const int wid = L.wid, lane = L.lane;
    asm volatile("" : "+s"(nt));
#pragma unroll
    for (int a = 0; a < 2; ++a)
#pragma unroll
        for (int b = 0; b < 2; ++b)
#pragma unroll
            for (int m = 0; m < 4; ++m)
#pragma unroll
                for (int n = 0; n < 2; ++n) acc[a][b][m][n] = (f32x4){0.f, 0.f, 0.f, 0.f};
    bf16x8 At[4][2], Bf0[2][2], Bf1[2][2];
    unsigned voffB[2];
    if (BMODE == 0) {
#pragma unroll
        for (int i = 0; i < 2; ++i) voffB[i] = (unsigned)L.Rb[i] * ldb_bytes + (unsigned)L.Cb16[i] * 16u;
    }
    const char* bp = nullptr; unsigned bw_base = 0;
    if (BMODE == 1) { bp = ((lane >> 5) ? B1 : B0) + (lane & 31) * 16; bw_base = (unsigned)((lane >> 5) * HTB + (wid * 8) * 256 + (lane & 3) * 8); }
    f32x4 X[4], Y[4];

#define G_STAGE_A(buf, kt) do { _Pragma("unroll") for (int _h = 0; _h < NAI; ++_h) _Pragma("unroll") for (int _i = 0; _i < 2; ++_i) \
        __builtin_amdgcn_global_load_lds((const unsigned*)(Ab + (size_t)(kt) * 128 + voffA[_h][_i]), (LAS unsigned*)(lds + SA_OFF(buf, _h) + wid * 1024 + _i * 8192), 16, 0, 0); } while (0)
#define G_STAGE_B(buf, kt) do { const char* _bb = B0 + (size_t)(kt) * 64 * ldb_bytes; _Pragma("unroll") for (int _h = 0; _h < 2; ++_h) _Pragma("unroll") for (int _i = 0; _i < 2; ++_i) \
        __builtin_amdgcn_global_load_lds((const unsigned*)(_bb + _h * 256 + voffB[_i]), (LAS unsigned*)(lds + SB_OFF(buf, _h) + wid * 1024 + _i * 8192), 16, 0, 0); } while (0)
#define G_LOADX(V, j0, kt) do { _Pragma("unroll") for (int _j = 0; _j < 4; ++_j) V[_j] = *(const f32x4*)(bp + (size_t)((kt) * 64 + wid * 8 + (j0) + _j) * ldb_bytes); } while (0)
#define G_WRITEX(V, j0, buf) do { _Pragma("unroll") for (int _j = 0; _j < 4; ++_j) { const int _jj = (j0) + _j; const int _f = (_jj & 3) | ((wid & 1) << 2); \
        u32x2 _w; _w.x = cvt_pk(V[_j][0], V[_j][1]); _w.y = cvt_pk(V[_j][2], V[_j][3]); \
        *(LAS u32x2*)(lds + SB_OFF(buf, 0) + bw_base + _jj * 256 + ((((lane & 31) >> 2) ^ _f) * 32)) = _w; } } while (0)
#define G_LDA(buf, h) do { _Pragma("unroll") for (int _m = 0; _m < 4; ++_m) _Pragma("unroll") for (int _k = 0; _k < 2; ++_k) \
        At[_m][_k] = *(const LAS bf16x8*)(lds + SA_OFF(buf, h) + L.aoff + _m * 2048 + _k * 1024); } while (0)
#define G_LDB(dst, buf, h) ldb_tr(dst, (unsigned)(size_t)lds + SB_OFF(buf, h) + L.boff[0], (unsigned)(size_t)lds + SB_OFF(buf, h) + L.boff[1])
#define G_MMA(ai, bj, Bt) do { _Pragma("unroll") for (int _m = 0; _m < 4; ++_m) _Pragma("unroll") for (int _n = 0; _n < 2; ++_n) _Pragma("unroll") for (int _k = 0; _k < 2; ++_k) \
        acc[ai][bj][_m][_n] = __builtin_amdgcn_mfma_f32_16x16x32_bf16(Bt[_n][_k], At[_m][_k], acc[ai][bj][_m][_n], 0, 0, 0); } while (0)

    WAIT_V(0); WAIT_L0(); BAR();
    if (BMODE == 0) {
        G_STAGE_A(0, 0); G_STAGE_B(0, 0);
#define G_ITER0(p, t) do { WAIT_V(0); BAR(); \
            if ((t) + 1 < nt) { G_STAGE_A(1 - (p), (t) + 1); G_STAGE_B(1 - (p), (t) + 1); } \
            G_LDB(Bf0, p, 0); G_LDA(p, 0); G_MMA(0, 0, Bf0); G_LDB(Bf1, p, 1); G_MMA(0, 1, Bf1); \
            if (NAI == 2) { G_LDA(p, 1); G_MMA(1, 0, Bf0); G_MMA(1, 1, Bf1); } } while (0)
        for (int t = 0; t < nt; t += 2) { G_ITER0(0, t); G_ITER0(1, t + 1); }
#undef G_ITER0
    } else {
        G_LOADX(X, 0, 0); G_LOADX(Y, 4, 0); G_STAGE_A(0, 0);
        WAIT_V(0);
        G_WRITEX(X, 0, 0); G_WRITEX(Y, 4, 0);
        if (nt > 1) { G_LOADX(X, 0, 1); G_LOADX(Y, 4, 1); }
#define G_LDA2(buf, h, mh) do { _Pragma("unroll") for (int _m = 0; _m < 2; ++_m) _Pragma("unroll") for (int _k = 0; _k < 2; ++_k) \
        At[_m][_k] = *(const LAS bf16x8*)(lds + SA_OFF(buf, h) + L.aoff + ((mh) * 2 + _m) * 2048 + _k * 1024); } while (0)
#define G_MMA2(ai, bj, mh) do { _Pragma("unroll") for (int _m = 0; _m < 2; ++_m) _Pragma("unroll") for (int _n = 0; _n < 2; ++_n) _Pragma("unroll") for (int _k = 0; _k < 2; ++_k) \
        acc[ai][bj][(mh) * 2 + _m][_n] = __builtin_amdgcn_mfma_f32_16x16x32_bf16(Bf0[_n][_k], At[_m][_k], acc[ai][bj][(mh) * 2 + _m][_n], 0, 0, 0); } while (0)
#define G_BLK(p, ai, bj) do { G_LDA2(p, ai, 0); G_MMA2(ai, bj, 0); G_LDA2(p, ai, 1); G_MMA2(ai, bj, 1); } while (0)
#define G_ITER1(p, t) do { const bool _n1 = ((t) + 1 < nt), _n2 = ((t) + 2 < nt); \
            if (_n1) { WAIT_V(8); } else { WAIT_V(0); } WAIT_L0(); BAR(); \
            if (_n1) { G_STAGE_A(1 - (p), (t) + 1); } \
            G_LDB(Bf0, p, 0); G_BLK(p, 0, 0); if (NAI == 2) { G_BLK(p, 1, 0); } \
            if (_n1) { WAIT_V(8); G_WRITEX(X, 0, 1 - (p)); if (_n2) { G_LOADX(X, 0, (t) + 2); } } \
            G_LDB(Bf0, p, 1); G_BLK(p, 0, 1); \
            if (_n1) { if (_n2) { WAIT_V(8); } else { WAIT_V(4); } G_WRITEX(Y, 4, 1 - (p)); if (_n2) { G_LOADX(Y, 4, (t) + 2); } } \
            if (NAI == 2) { G_BLK(p, 1, 1); } } while (0)
        for (int t = 0; t < nt; t += 2) { G_ITER1(0, t); G_ITER1(1, t + 1); }
#undef G_ITER1
#undef G_BLK
#undef G_MMA2
#undef G_LDA2
    }
#undef G_STAGE_A
#undef G_STAGE_B
#undef G_LOADX
#undef G_WRITEX
#undef G_LDA
#undef G_LDB
#undef G_MMA
}

template <class AP, class BP, class EP>
__device__ __forceinline__ void gemm_stream(LAS unsigned char* lds, const GemmLane& L, int K, int lda, int ldb, size_t hstepA, int nunits, int G, int vcu, const AP& aptr, const BP& bptr, const EP& epi) {
    const int wid = L.wid, wr = L.wr;
    int nt = K / 64; asm volatile("" : "+s"(nt));
    unsigned voffA[2], voffB[2];
#pragma unroll
    for (int i = 0; i < 2; ++i) { voffA[i] = (unsigned)((L.Ra[i] * lda + L.Ca[i]) * 2); voffB[i] = (unsigned)L.Rb[i] * (unsigned)(ldb * 2) + (unsigned)L.Cb16[i] * 16u; }
    const size_t kstepA = 128, kstepB = (size_t)64 * ldb * 2, hstepB = 256;
    const unsigned ldsw = (unsigned)wid * 1024u;
#define S_STAGE(bufoff, gbase, voff) do { _Pragma("unroll") for (int _i = 0; _i < 2; ++_i) \
        __builtin_amdgcn_global_load_lds((const unsigned*)((const char*)(gbase) + (voff)[_i]), (LAS unsigned*)(lds + (bufoff) + ldsw + _i * 8192), 16, 0, 0); } while (0)
#define S_LDA(dst, b, h) do { _Pragma("unroll") for (int _m = 0; _m < 4; ++_m) _Pragma("unroll") for (int _k = 0; _k < 2; ++_k) \
        dst[_m][_k] = *(const LAS bf16x8*)(lds + SA_OFF(b, h) + L.aoff + _m * 2048 + _k * 1024); } while (0)
#define S_LDB(dst, b, h) ldb_tr(dst, (unsigned)(size_t)lds + SB_OFF(b, h) + L.boff[0], (unsigned)(size_t)lds + SB_OFF(b, h) + L.boff[1])
#define S_MMA(ai, bj, Bt) do { __builtin_amdgcn_s_setprio(1); _Pragma("unroll") for (int _m = 0; _m < 4; ++_m) _Pragma("unroll") for (int _n = 0; _n < 2; ++_n) _Pragma("unroll") for (int _k = 0; _k < 2; ++_k) \
        acc[ai][bj][_m][_n] = __builtin_amdgcn_mfma_f32_16x16x32_bf16(Bt[_n][_k], At[_m][_k], acc[ai][bj][_m][_n], 0, 0, 0); __builtin_amdgcn_s_setprio(0); } while (0)
#define S_SCHED __builtin_amdgcn_sched_barrier(0)
#define S_ZERO() do { _Pragma("unroll") for (int _a = 0; _a < 2; ++_a) _Pragma("unroll") for (int _b = 0; _b < 2; ++_b) _Pragma("unroll") for (int _m = 0; _m < 4; ++_m) _Pragma("unroll") for (int _n = 0; _n < 2; ++_n) \
        acc[_a][_b][_m][_n] = (f32x4){0.f, 0.f, 0.f, 0.f}; } while (0)
    int ucur = vcu, ui = 0;
    if (ucur >= nunits) return;
    f32x4 acc[2][2][4][2];
    S_ZERO();
    bf16x8 At[4][2], B0[2][2], B1[2][2];
    const char* cA = aptr(ucur); const char* cB = bptr(ucur);
    WAIT_V(0); WAIT_L0(); BAR();
    S_STAGE(SB_OFF(0, 0), cB, voffB); S_STAGE(SB_OFF(0, 1), cB + hstepB, voffB); S_STAGE(SA_OFF(0, 0), cA, voffA); S_STAGE(SA_OFF(0, 1), cA + hstepA, voffA);
    if (wr == 1) BAR();
    WAIT_V(2); BAR();
    S_STAGE(SB_OFF(1, 0), cB + kstepB, voffB); S_STAGE(SA_OFF(1, 0), cA + kstepA, voffA); S_STAGE(SB_OFF(1, 1), cB + hstepB + kstepB, voffB);
    WAIT_V(6); BAR();
    for (;;) {
        const int unext = (ui + 1) * G + vcu; const bool has_next = unext < nunits;
        const char* nA = has_next ? aptr(unext) : cA; const char* nB = has_next ? bptr(unext) : cB;
        for (int t = 0; t < nt; t += 2) {
            const bool last = (t == nt - 2);
            const char* a1 = cA + (size_t)(t + 1) * kstepA;
            const char* a2 = last ? nA : cA + (size_t)(t + 2) * kstepA; const char* b2 = last ? nB : cB + (size_t)(t + 2) * kstepB;
            const char* a3 = a2 + kstepA; const char* b3 = b2 + kstepB;
            S_LDB(B0, 0, 0); S_LDB(B1, 0, 1); S_SCHED; S_LDA(At, 0, 0); S_STAGE(SA_OFF(1, 1), a1 + hstepA, voffA);
            WAIT_V(8); WAIT_L0(); BAR(); S_MMA(0, 0, B0); S_MMA(0, 1, B1); BAR(); S_SCHED;
            S_LDA(At, 0, 1); S_STAGE(SB_OFF(0, 0), b2, voffB); S_STAGE(SB_OFF(0, 1), b2 + hstepB, voffB); S_STAGE(SA_OFF(0, 0), a2, voffA);
            WAIT_V(8); WAIT_L0(); BAR(); S_MMA(1, 0, B0); S_MMA(1, 1, B1); BAR(); S_SCHED;
            S_LDB(B0, 1, 0); S_LDB(B1, 1, 1); S_SCHED; S_LDA(At, 1, 0); S_STAGE(SA_OFF(0, 1), a2 + hstepA, voffA);
            WAIT_V(8); WAIT_L0(); BAR(); S_MMA(0, 0, B0); S_MMA(0, 1, B1); BAR(); S_SCHED;
            S_LDA(At, 1, 1); S_STAGE(SB_OFF(1, 0), b3, voffB); S_STAGE(SB_OFF(1, 1), b3 + hstepB, voffB); S_STAGE(SA_OFF(1, 0), a3, voffA);
            WAIT_V(8); WAIT_L0(); BAR(); S_MMA(1, 0, B0); S_MMA(1, 1, B1); BAR(); S_SCHED;
        }
        if (wr == 0) BAR();
        epi(acc, ucur);
        if (!has_next) break;
        S_ZERO();
        ucur = unext; cA = nA; cB = nB; ++ui;
        if (wr == 1) BAR();
    }
    WAIT_V(0);
    BAR();
#undef S_STAGE
#undef S_LDA
#undef S_LDB
#undef S_MMA
#undef S_SCHED
#undef S_ZERO
}

struct Args {
    const float* in[22]; float* out; unsigned char* ws; int ph_lo, ph_hi;
};

__device__ __forceinline__ float gelu_tanh(float v) {
    const float u = 0.7978845608028654f * (v + 0.044715f * v * v * v);
    return v * __builtin_amdgcn_rcpf(1.f + __builtin_amdgcn_exp2f(-2.885390081777927f * u));
}
__device__ __forceinline__ float silu_f(float v) { return v * __builtin_amdgcn_rcpf(1.f + __builtin_amdgcn_exp2f(-1.4426950408889634f * v)); }

__device__ __forceinline__ void norm_token(int lane, const float* xrow, const bf16_t* y0, const bf16_t* y1, const float* gate, float* xout,
                                           const float* g, const float* shift, const float* scale, bf16_t* hout, float* fout) {
    f32x4 v[8]; float ss = 0.f;
#pragma unroll
    for (int j = 0; j < 8; ++j) {
        const int d = 4 * lane + 256 * j;
        f32x4 xv = *(const f32x4*)(xrow + d);
        if (y0) {
            const u32x2 a = *(const u32x2*)(y0 + d), b = *(const u32x2*)(y1 + d); const f32x4 gt = *(const f32x4*)(gate + d);
            xv[0] += gt[0] * (bf_lo(a.x) + bf_lo(b.x)); xv[1] += gt[1] * (bf_hi(a.x) + bf_hi(b.x));
            xv[2] += gt[2] * (bf_lo(a.y) + bf_lo(b.y)); xv[3] += gt[3] * (bf_hi(a.y) + bf_hi(b.y));
            if (xout) *(f32x4*)(xout + d) = xv;
        }
        v[j] = xv; ss += (xv[0] * xv[0] + xv[1] * xv[1]) + (xv[2] * xv[2] + xv[3] * xv[3]);
    }
    const float rstd = rsqrtf(wave_sum(ss) * (1.f / D) + EPS);
#pragma unroll
    for (int j = 0; j < 8; ++j) {
        const int d = 4 * lane + 256 * j;
        const f32x4 gg = *(const f32x4*)(g + d); f32x4 h = v[j] * rstd * gg;
        if (scale) { const f32x4 sc = *(const f32x4*)(scale + d), sh = *(const f32x4*)(shift + d); h = h * (1.f + sc) + sh; }
        if (hout) { u32x2 w; w.x = cvt_pk(h[0], h[1]); w.y = cvt_pk(h[2], h[3]); *(u32x2*)(hout + d) = w; }
        if (fout) *(f32x4*)(fout + d) = h;
    }
}

__global__ void __launch_bounds__(512, 2) mk_fwd(Args args) {
    extern __shared__ __attribute__((aligned(16))) unsigned char lds_raw[];
    LAS unsigned char* lds = (LAS unsigned char*)lds_raw;
    volatile LAS unsigned* MISC = (volatile LAS unsigned*)(lds + MISC_OFF);
    const int wid = __builtin_amdgcn_readfirstlane((int)threadIdx.x >> 6);
#define GET_TID const int lane = opaque_lane(); const int tid = wid * 64 + lane; (void)tid
    const int G = gridDim.x; const int bx = blockIdx.x;
    const int vcu = (G % 8 == 0) ? (bx % 8) * (G / 8) + bx / 8 : bx;
    unsigned char* ws = args.ws;
    unsigned* ctl = (unsigned*)(ws + WS_CTL);
    XcdBarrier bar;
    { GET_TID; if (tid < 4) MISC[tid] = 0u;
      __syncthreads();
      bar = xcd_barrier_post(ctl + CW_BAR, MISC, tid); }
    const int lo = args.ph_lo, hi = args.ph_hi;
#ifndef PH_MASK
#define PH_MASK 0x1FFFF
#endif
#define IN(k) (((PH_MASK >> (k)) & 1) && lo <= (k) && (k) < hi)
#ifndef PROBE_REP
#define PROBE_REP 0
#endif
#define REP(k) ((((PROBE_REP) >> (k)) & 1) ? 2 : 1)
#define REPBAR() do { if (r_ > 0) { const int l2_ = opaque_lane(); xcd_barrier(bar, wid * 64 + l2_); } } while (0)
#define SEAM(k) do { if (IN(k) && IN((k) + 1)) { GET_TID; xcd_barrier(bar, tid); } } while (0)

#define x_in     (args.in[0])
#define c_in     (args.in[1])
#define g_norm1  (args.in[2])
#define g_norm2  (args.in[3])
#define w_ada    (args.in[4])
#define b_ada    (args.in[5])
#define fa_w_in  (args.in[6])
#define fa_w_out (args.in[7])
#define sg_w_in  (args.in[8])
#define sg_b_in  (args.in[9])
#define sg_g_v   (args.in[10])
#define sg_w_s   (args.in[11])
#define sg_b_s   (args.in[12])
#define sg_w_out (args.in[13])
#define w_group  (args.in[14])
#define b_group  (args.in[15])
#define w_router (args.in[16])
#define b_router (args.in[17])
#define w_gate   (args.in[18])
#define w_up     (args.in[19])
#define w_down   (args.in[20])
#define g_final  (args.in[21])
#define mod    ((float*)(args.ws + WS_MOD))
#define Wfin   ((bf16_t*)(args.ws + WS_WFIN))
#define Wfout  ((bf16_t*)(args.ws + WS_WFOUT))
#define Wsgin  ((bf16_t*)(args.ws + WS_WSGIN))
#define Wsgout ((bf16_t*)(args.ws + WS_WSGOUT))
#define DFTC   ((bf16_t*)(args.ws + WS_DFTC))
#define DFTS   ((bf16_t*)(args.ws + WS_DFTS))
#define hA     ((bf16_t*)(args.ws + WS_HA))
#define zB     ((bf16_t*)(args.ws + WS_ZB))
#define T2     ((bf16_t*)(args.ws + WS_T2))
#define fB     ((bf16_t*)(args.ws + WS_FB))
#define ubuf   T2
#define vbuf   (T2 + (size_t)T * D)
#define xa     ((float*)(args.ws + WS_XA))
#define xb     ((float*)(args.ws + WS_XB))
#define act    ((bf16_t*)(args.ws + WS_ACT))
#define ybuf   ((bf16_t*)(args.ws + WS_YB))
#define vss    ((float*)(args.ws + WS_VSS))
#define lists  ((int*)(args.ws + WS_LISTS))
#define tokw   ((float*)(args.ws + WS_TOKW))
#define LANE_SETUP GET_TID; const GemmLane L = make_lane(tid); const int wr = L.wr, wc = L.wc, fr = L.fr, fq = L.fq; f32x4 acc[2][2][4][2]; (void)wr; (void)wc; (void)fr; (void)fq

    if (IN(0)) for (int r_ = 0; r_ < REP(0); ++r_) { REPBAR(); GET_TID;
        {
            LAS float* ca = (LAS float*)lds;
            for (int i = tid; i < NB * D; i += 512) { const float v = c_in[i]; ca[i] = v / (1.f + __expf(-v)); }
            __syncthreads();
            for (int slab = bx; slab < 256; slab += G) {
            const int col0 = slab * 96; const int l = col0 / (6 * D), j0 = col0 % (6 * D);
            const int sub = lane / 24, c4 = lane % 24; const bool act_lane = lane < 48;
            f32x4 a0 = {0, 0, 0, 0}, a1 = a0, a2 = a0, a3 = a0;
            if (act_lane) {
                const float* wp = w_ada + (size_t)l * D * 6 * D + j0 + 4 * c4;
#pragma unroll 8
                for (int it = 0; it < 128; ++it) {
                    const int k = 256 * wid + 2 * it + sub;
                    const f32x4 wv = *(const f32x4*)(wp + (size_t)k * 6 * D);
                    a0 += ca[k] * wv; a1 += ca[D + k] * wv; a2 += ca[2 * D + k] * wv; a3 += ca[3 * D + k] * wv;
                }
            }
            __syncthreads();
            LAS float* red = (LAS float*)(lds + 32768);
            if (act_lane) { LAS f32x4* r = (LAS f32x4*)(red + (wid * 48 + lane) * 16); r[0] = a0; r[1] = a1; r[2] = a2; r[3] = a3; }
            __syncthreads();
            if (tid < 384) {
                const int b = tid / 96, cc = tid % 96, c4i = cc >> 2, e = cc & 3; float s = 0.f;
#pragma unroll
                for (int w = 0; w < 8; ++w)
#pragma unroll
                    for (int sb = 0; sb < 2; ++sb) s += red[(w * 48 + sb * 24 + c4i) * 16 + b * 4 + e];
                mod[((size_t)l * NB + b) * 6 * D + j0 + cc] = s + b_ada[l * 6 * D + j0 + cc];
            }
            __syncthreads();
            }
        }
        {
            const size_t gtid = (size_t)vcu * 512 + tid, gstride = (size_t)G * 512;
            auto conv = [&](const float* src, bf16_t* dst, size_t n8) {
                for (size_t i = gtid; i < n8; i += gstride) { const f32x4 a = *(const f32x4*)(src + i * 8), b = *(const f32x4*)(src + i * 8 + 4);
                    u32x4 w; w.x = cvt_pk(a[0], a[1]); w.y = cvt_pk(a[2], a[3]); w.z = cvt_pk(b[0], b[1]); w.w = cvt_pk(b[2], b[3]); *(u32x4*)(dst + i * 8) = w; } };
            conv(fa_w_in, Wfin, (size_t)D * D / 8); conv(fa_w_out, Wfout, (size_t)D * D / 8);
            conv(sg_w_in, Wsgin, (size_t)D * 2 * D / 8); conv(sg_w_out, Wsgout, (size_t)D * D / 8);
            for (size_t i = gtid; i < (size_t)CG * 1024 / 8; i += gstride) {
                const int n2 = (int)(i / 128), j0 = (int)(i % 128) * 8; float v[8];
#pragma unroll
                for (int e = 0; e < 8; ++e) { const int j = j0 + e, k2 = j & 511; const float ang = (float)((k2 * n2) & 511) * (2.0f / 512.0f); v[e] = (j < 512 ? cospif(ang) : sinpif(ang)) * (1.0f / 32.0f); }
                u32x4 w; w.x = cvt_pk(v[0], v[1]); w.y = cvt_pk(v[2], v[3]); w.z = cvt_pk(v[4], v[5]); w.w = cvt_pk(v[6], v[7]); *(u32x4*)(DFTC + i * 8) = w;
            }
            for (size_t i = gtid; i < (size_t)S * 2048 / 8; i += gstride) {
                const int r = (int)(i / 256), kk0 = (int)(i % 256) * 8; const int k = r & 1023, par = r >> 10; float v[8];
#pragma unroll
                for (int e = 0; e < 8; ++e) { const int kk = kk0 + e, m = kk & 1023, n = 2 * m + par; const float ang = (float)((k * n) & 2047) * (2.0f / 2048.0f); v[e] = (kk < 1024 ? cospif(ang) : -sinpif(ang)) * (1.0f / 32.0f); }
                u32x4 w; w.x = cvt_pk(v[0], v[1]); w.y = cvt_pk(v[2], v[3]); w.z = cvt_pk(v[4], v[5]); w.w = cvt_pk(v[6], v[7]); *(u32x4*)(DFTS + i * 8) = w;
            }
        }
    }
    SEAM(0);

    if (IN(1)) for (int r_ = 0; r_ < REP(1); ++r_) { REPBAR(); GET_TID;
        for (int t = vcu * 8 + wid; t < T; t += G * 8) {
            const int b = t / S; const float* m = mod + (size_t)b * 6 * D;
            norm_token(lane, x_in + (size_t)t * D, nullptr, nullptr, nullptr, nullptr, g_norm1, m, m + D, hA + (size_t)t * D, nullptr);
        }
    }
    SEAM(1);

#define DENSE_UNIT(Aptr, lda, Bptr, ldb, Kdim) do { \
        unsigned _vo[2][2]; _Pragma("unroll") for (int _h = 0; _h < 2; ++_h) _Pragma("unroll") for (int _i = 0; _i < 2; ++_i) _vo[_h][_i] = (unsigned)(((_h * 128 + L.Ra[_i]) * (lda) + L.Ca[_i]) * 2); \
        gemm_unit<0, 2>(lds, L, (const char*)(Aptr), _vo, (const char*)(Bptr), nullptr, (unsigned)((ldb) * 2), (Kdim) / 64, acc); } while (0)

    if (IN(2)) for (int r_ = 0; r_ < REP(2); ++r_) { REPBAR(); LANE_SETUP;
        gemm_stream(lds, L, D, D, D, (size_t)128 * D * 2, 32 * 8, G, vcu,
            [&](int u) { return (const char*)(hA + (size_t)(u >> 3) * 256 * D); },
            [&](int u) { return (const char*)(Wfin + (u & 7) * 256); },
            [&](f32x4 (&acc)[2][2][4][2], int u) { const int pm = u >> 3, pn = u & 7;
#pragma unroll
            for (int ai = 0; ai < 2; ++ai)
#pragma unroll
                for (int m = 0; m < 4; ++m) { const int row = pm * 256 + ai * 128 + wr * 64 + m * 16 + fr;
#pragma unroll
                    for (int bj = 0; bj < 2; ++bj)
#pragma unroll
                        for (int n = 0; n < 2; ++n) { const int col = pn * 256 + bj * 128 + wc * 32 + n * 16 + 4 * fq; const f32x4 v = acc[ai][bj][m][n];
                            u32x2 w; w.x = cvt_pk(v[0], v[1]); w.y = cvt_pk(v[2], v[3]); *(u32x2*)(zB + (size_t)row * D + col) = w; } }
            });
    }
    SEAM(2);

    if (IN(3)) for (int r_ = 0; r_ < REP(3); ++r_) { REPBAR(); LANE_SETUP;
        gemm_stream(lds, L, CG, D, 1024, (size_t)128 * D * 2, 32 * 16, G, vcu,
            [&](int u) { const int pm = u >> 4, g = (u & 15) >> 2; return (const char*)(zB + (size_t)pm * 256 * D + g * CG); },
            [&](int u) { return (const char*)(DFTC + (u & 3) * 256); },
            [&](f32x4 (&acc)[2][2][4][2], int u) { const int pm = u >> 4, pn = u & 15, g = pn >> 2, ct = pn & 3;
            const int which = ct >> 1; const int cbase = g * CG + (ct & 1) * 256;
#pragma unroll
            for (int ai = 0; ai < 2; ++ai)
#pragma unroll
                for (int m = 0; m < 4; ++m) { const int row = pm * 256 + ai * 128 + wr * 64 + m * 16 + fr; const int b = row >> 11, n1 = row & 2047;
                    bf16_t* orow = T2 + ((size_t)(b * 2 + which) * S + n1) * D + cbase;
#pragma unroll
                    for (int bj = 0; bj < 2; ++bj)
#pragma unroll
                        for (int n = 0; n < 2; ++n) { const int col = bj * 128 + wc * 32 + n * 16 + 4 * fq; const f32x4 v = acc[ai][bj][m][n];
                            u32x2 w; w.x = cvt_pk(v[0], v[1]); w.y = cvt_pk(v[2], v[3]); *(u32x2*)(orow + col) = w; } }
            });
    }
    SEAM(3);

    if (IN(4)) for (int r_ = 0; r_ < REP(4); ++r_) { REPBAR(); LANE_SETUP;
        gemm_stream(lds, L, 2048, 2048, 2 * D, (size_t)128 * 2048 * 2, 32 * 8, G, vcu,
            [&](int u) { const int pk = (u >> 3) & 7; return (const char*)(DFTS + (size_t)pk * 256 * 2048); },
            [&](int u) { const int pm = u >> 3, pn = u & 7, b = pm >> 3, par = (pm & 7) >> 2; return (const char*)(T2 + (size_t)b * 2 * S * D + (size_t)par * D + pn * 256); },
            [&](f32x4 (&acc)[2][2][4][2], int u) { const int pm = u >> 3, pn = u & 7;
#pragma unroll
            for (int ai = 0; ai < 2; ++ai)
#pragma unroll
                for (int m = 0; m < 4; ++m) { const int row = pm * 256 + ai * 128 + wr * 64 + m * 16 + fr;
#pragma unroll
                    for (int bj = 0; bj < 2; ++bj)
#pragma unroll
                        for (int n = 0; n < 2; ++n) { const int col = pn * 256 + bj * 128 + wc * 32 + n * 16 + 4 * fq; const f32x4 v = acc[ai][bj][m][n];
                            u32x2 w; w.x = cvt_pk(v[0], v[1]); w.y = cvt_pk(v[2], v[3]); *(u32x2*)(fB + (size_t)row * D + col) = w; } }
            });
    }
    SEAM(4);

#define RESID_EPI(basep, gatep, dstp) do { \
        _Pragma("unroll") for (int ai = 0; ai < 2; ++ai) _Pragma("unroll") for (int m = 0; m < 4; ++m) { const int row = pm * 256 + ai * 128 + wr * 64 + m * 16 + fr; const int b = row >> 11; \
            _Pragma("unroll") for (int bj = 0; bj < 2; ++bj) _Pragma("unroll") for (int n = 0; n < 2; ++n) { const int col = pn * 256 + bj * 128 + wc * 32 + n * 16 + 4 * fq; \
                const f32x4 gt = *(const f32x4*)((gatep) + (size_t)b * 6 * D + col); const f32x4 bs = *(const f32x4*)((basep) + (size_t)row * D + col); \
                *(f32x4*)((dstp) + (size_t)row * D + col) = bs + gt * acc[ai][bj][m][n]; } } } while (0)

    if (IN(5)) for (int r_ = 0; r_ < REP(5); ++r_) { REPBAR(); LANE_SETUP;
        gemm_stream(lds, L, D, D, D, (size_t)1024 * D * 2, 32 * 8, G, vcu,
            [&](int u) { const int pm = u >> 3, b = pm >> 3, kt = pm & 7; return (const char*)(fB + ((size_t)b * S + kt * 128) * D); },
            [&](int u) { return (const char*)(Wfout + (u & 7) * 256); },
            [&](f32x4 (&acc)[2][2][4][2], int u) { const int pm = u >> 3, pn = u & 7, b = pm >> 3, kt = pm & 7;
            const float* gtp = mod + (size_t)b * 6 * D + 2 * D;
#pragma unroll
            for (int m = 0; m < 4; ++m) { const int k = kt * 128 + wr * 64 + m * 16 + fr; const size_t r0 = (size_t)b * S + k, r1 = r0 + 1024;
#pragma unroll
                for (int bj = 0; bj < 2; ++bj)
#pragma unroll
                    for (int n = 0; n < 2; ++n) { const int col = pn * 256 + bj * 128 + wc * 32 + n * 16 + 4 * fq;
                        const f32x4 gt = *(const f32x4*)(gtp + col); const f32x4 ye = acc[0][bj][m][n], yo = acc[1][bj][m][n];
                        const f32x4 x0 = *(const f32x4*)(x_in + r0 * D + col), x1 = *(const f32x4*)(x_in + r1 * D + col);
                        *(f32x4*)(xa + r0 * D + col) = x0 + gt * (ye + yo); *(f32x4*)(xa + r1 * D + col) = x1 + gt * (ye - yo); } }
            });
    }
    SEAM(5);

    auto route_phase = [&](int l, const float* xsrc) { GET_TID;
        const float* g2 = g_norm2 + l * D; const float* m_l = mod + (size_t)l * NB * 6 * D;
        const float* wg = w_group + (size_t)l * D * NG; const float* wrt = w_router + (size_t)l * D * NE;
        const float* bg = b_group + l * NG; const float* brt = b_router + l * NE;
        unsigned* counts = ctl + CW_COUNTS + l * 32; int* lst = lists + (size_t)l * NE * T; float* tw = tokw + (size_t)l * T * 2;
        LAS float* wl = (LAS float*)lds;
        LAS float* lg4 = (LAS float*)(lds + 40960);
        LAS int* sel = (LAS int*)(lds + 40960 + 18432);
        LAS int* rnk = sel + 64;
        LAS int* hist = rnk + 64;
        LAS int* gbase = hist + 32;
#pragma unroll 1
        for (int tb = vcu * 32; tb < T; tb += G * 32) {
            const int b = tb / S; const int tk0 = tb + wid * 4;
            const float* scp = m_l + (size_t)b * 6 * D + 4 * D; const float* shp = m_l + (size_t)b * 6 * D + 3 * D;
            float rstd[4];
#pragma unroll
            for (int k = 0; k < 4; ++k) { const float* xr = xsrc + (size_t)(tk0 + k) * D; float ss = 0.f;
#pragma unroll 8
                for (int i = 0; i < 32; ++i) { const float v = xr[64 * i + lane]; ss += v * v; }
                rstd[k] = rsqrtf(wave_sum(ss) * (1.f / D) + EPS); }
            f32x2 a2[4][18];
#pragma unroll
            for (int k = 0; k < 4; ++k)
#pragma unroll
                for (int o = 0; o < 18; ++o) a2[k][o] = (f32x2){0.f, 0.f};
            if (tid < 32) hist[tid] = 0;
#pragma unroll 1
            for (int j = 0; j < 8; ++j) {
                __syncthreads();
                for (int i = tid; i < 256 * 8; i += 512) { const int ch = i >> 3, c4 = i & 7; const f32x4 v = *(const f32x4*)(wrt + (size_t)(256 * j + ch) * NE + 4 * c4); *(LAS f32x4*)(wl + ch * 36 + 4 + 4 * c4) = v; }
                if (tid < 256) { const f32x4 v = *(const f32x4*)(wg + (size_t)(256 * j + tid) * NG); *(LAS f32x4*)(wl + tid * 36) = v; }
                __syncthreads();
#pragma unroll 1
                for (int cc = 0; cc < 4; ++cc) {
                    const int d = 256 * j + 64 * cc + lane;
                    const float gsc = g2[d] * (1.f + scp[d]), shv = shp[d];
                    f32x2 h2[4];
#pragma unroll
                    for (int k = 0; k < 4; ++k) { const float hh = xsrc[(size_t)(tk0 + k) * D + d] * rstd[k] * gsc + shv; h2[k] = (f32x2){hh, hh};
                        hA[(size_t)(tk0 + k) * D + d] = (bf16_t)(cvt_pk(hh, 0.f) & 0xffffu); }
                    const LAS f32x4* wrow = (const LAS f32x4*)(wl + (cc * 64 + lane) * 36);
#pragma unroll
                    for (int q = 0; q < 9; ++q) { const f32x4 wv = wrow[q]; const f32x2 w01 = (f32x2){wv[0], wv[1]}, w23 = (f32x2){wv[2], wv[3]};
#pragma unroll
                        for (int k = 0; k < 4; ++k) { a2[k][2 * q] += h2[k] * w01; a2[k][2 * q + 1] += h2[k] * w23; } }
                }
            }
#pragma unroll
            for (int k = 0; k < 4; ++k)
#pragma unroll
                for (int o = 0; o < 36; ++o) { const float r = row_sum16(a2[k][o >> 1][o & 1]); if ((lane & 15) == 0) lg4[((wid * 4 + k) * 36 + o) * 4 + (lane >> 4)] = r; }
            __syncthreads();
            if (tid < 32) {
                const LAS f32x4* lp = (const LAS f32x4*)(lg4 + tid * 36 * 4);
                float gl[4];
#pragma unroll
                for (int i = 0; i < 4; ++i) { const f32x4 v = lp[i]; gl[i] = ((v[0] + v[1]) + (v[2] + v[3])) + bg[i]; }
                int gi = 0; float gm = gl[0];
#pragma unroll
                for (int i = 1; i < 4; ++i) if (gl[i] > gm) { gm = gl[i]; gi = i; }
                float se = 0.f;
#pragma unroll
                for (int i = 0; i < 4; ++i) se += __expf(gl[i] - gm);
                const float gw = 1.f / se;
                float el[8];
#pragma unroll
                for (int i = 0; i < 8; ++i) { const f32x4 v = lp[4 + gi * 8 + i]; el[i] = ((v[0] + v[1]) + (v[2] + v[3])) + brt[gi * 8 + i]; }
                int i0 = 0; float v0 = el[0];
#pragma unroll
                for (int i = 1; i < 8; ++i) if (el[i] > v0) { v0 = el[i]; i0 = i; }
                int i1 = 0; float v1 = -3.4e38f;
#pragma unroll
                for (int i = 0; i < 8; ++i) if (i != i0 && el[i] > v1) { v1 = el[i]; i1 = i; }
                const float e1 = __expf(v1 - v0); const float p0 = 1.f / (1.f + e1), p1 = e1 / (1.f + e1);
                const int tk = tb + tid; const int ex0 = gi * EPG + i0, ex1 = gi * EPG + i1;
                tw[tk * 2 + 0] = p0 * gw; tw[tk * 2 + 1] = p1 * gw;
                sel[tid * 2] = ex0; sel[tid * 2 + 1] = ex1;
                rnk[tid * 2] = atomicAdd((int*)&hist[ex0], 1); rnk[tid * 2 + 1] = atomicAdd((int*)&hist[ex1], 1);
            }
            __syncthreads();
            if (tid < 32) { const int c = hist[tid]; gbase[tid] = c > 0 ? (int)atomicAdd(&counts[tid], (unsigned)c) : 0; }
            __syncthreads();
            if (tid < 64) { const int e = sel[tid]; lst[(size_t)e * T + gbase[e] + rnk[tid]] = (tb + (tid >> 1)) * 2 + (tid & 1); }
            __syncthreads();
        }
    };

    auto moe1_phase = [&](int l) { LANE_SETUP;
        const unsigned* counts = ctl + CW_COUNTS + l * 32; const int* lst = lists + (size_t)l * NE * T;
        const float* WG = w_gate + (size_t)l * NE * D * DE; const float* WU = w_up + (size_t)l * NE * D * DE;
        int ustart = 0, base = 0;
#pragma unroll 1
        for (int e = 0; e < NE; ++e) {
            const int cnt = (int)counts[e]; const int nrt = (cnt + 255) >> 8; const int nun = nrt * 4;
            int first = vcu - (ustart % G); if (first < 0) first += G;
#pragma unroll 1
            for (int r = first; r < nun; r += G) {
                const int ct = r / nrt, rt = r % nrt;
                unsigned vo[2][2];
#pragma unroll
                for (int hh = 0; hh < 2; ++hh)
#pragma unroll
                    for (int i = 0; i < 2; ++i) { const int mrow = rt * 256 + hh * 128 + L.Ra[i]; const int ent = (mrow < cnt) ? lst[(size_t)e * T + mrow] : 0; vo[hh][i] = (unsigned)(((ent >> 1) * D + L.Ca[i]) * 2); }
                const float* wgp = WG + (size_t)e * D * DE + ct * 128; const float* wup = WU + (size_t)e * D * DE + ct * 128;
                gemm_unit<1, 2>(lds, L, (const char*)hA, vo, (const char*)wgp, (const char*)wup, (unsigned)(DE * 4), D / 64, acc);
#pragma unroll
                for (int ai = 0; ai < 2; ++ai)
#pragma unroll
                    for (int m = 0; m < 4; ++m) { const int mrow = rt * 256 + ai * 128 + wr * 64 + m * 16 + fr;
                        if (mrow < cnt) { bf16_t* orow = act + (size_t)(base + mrow) * DE + ct * 128;
#pragma unroll
                            for (int n = 0; n < 2; ++n) { const f32x4 gv = acc[ai][0][m][n], uv = acc[ai][1][m][n];
                                u32x2 w; w.x = cvt_pk(silu_f(gv[0]) * uv[0], silu_f(gv[1]) * uv[1]); w.y = cvt_pk(silu_f(gv[2]) * uv[2], silu_f(gv[3]) * uv[3]);
                                *(u32x2*)(orow + wc * 32 + n * 16 + 4 * fq) = w; } }
                        asm volatile("" ::: "memory"); }
            }
            ustart += nun; base += cnt;
        }
    };
    auto moe2_phase = [&](int l) { LANE_SETUP;
        const unsigned* counts = ctl + CW_COUNTS + l * 32; const int* lst = lists + (size_t)l * NE * T; const float* tw = tokw + (size_t)l * T * 2;
        const float* WD = w_down + (size_t)l * NE * DE * D;
        int ustart = 0, base = 0;
#pragma unroll 1
        for (int e = 0; e < NE; ++e) {
            const int cnt = (int)counts[e]; const int nrt = (cnt + 255) >> 8; const int nun = nrt * 8;
            int first = vcu - (ustart % G); if (first < 0) first += G;
#pragma unroll 1
            for (int r = first; r < nun; r += G) {
                const int ct = r / nrt, rt = r % nrt;
                unsigned vo[2][2];
#pragma unroll
                for (int hh = 0; hh < 2; ++hh)
#pragma unroll
                    for (int i = 0; i < 2; ++i) vo[hh][i] = (unsigned)(((hh * 128 + L.Ra[i]) * DE + L.Ca[i]) * 2);
                const float* wdp = WD + (size_t)e * DE * D + ct * 256;
                gemm_unit<1, 2>(lds, L, (const char*)(act + (size_t)(base + rt * 256) * DE), vo, (const char*)wdp, (const char*)(wdp + 128), (unsigned)(D * 4), DE / 64, acc);
#pragma unroll
                for (int ai = 0; ai < 2; ++ai)
#pragma unroll
                    for (int m = 0; m < 4; ++m) { const int mrow = rt * 256 + ai * 128 + wr * 64 + m * 16 + fr;
                        if (mrow < cnt) { const int ent = lst[(size_t)e * T + mrow]; const float w8 = tw[ent]; bf16_t* orow = ybuf + (size_t)ent * D + ct * 256;
#pragma unroll
                            for (int bj = 0; bj < 2; ++bj)
#pragma unroll
                                for (int n = 0; n < 2; ++n) { const f32x4 v = acc[ai][bj][m][n] * w8;
                                    u32x2 w; w.x = cvt_pk(v[0], v[1]); w.y = cvt_pk(v[2], v[3]); *(u32x2*)(orow + bj * 128 + wc * 32 + n * 16 + 4 * fq) = w; } }
                        asm volatile("" ::: "memory"); }
            }
            ustart += nun; base += cnt;
        }
    };

    if (IN(6)) route_phase(0, xa);
    SEAM(6);
    if (IN(7)) for (int r_ = 0; r_ < REP(7); ++r_) { REPBAR(); moe1_phase(0); }
    SEAM(7);
    if (IN(8)) for (int r_ = 0; r_ < REP(8); ++r_) { REPBAR(); moe2_phase(0); }
    SEAM(8);

    if (IN(9)) for (int r_ = 0; r_ < REP(9); ++r_) { REPBAR(); GET_TID;
        const float* m1 = mod + (size_t)NB * 6 * D;
        for (int t = vcu * 8 + wid; t < T; t += G * 8) {
            const int b = t / S;
            norm_token(lane, xa + (size_t)t * D, ybuf + (size_t)t * 2 * D, ybuf + (size_t)t * 2 * D + D, mod + (size_t)b * 6 * D + 5 * D, xb + (size_t)t * D,
                       g_norm1 + D, m1 + (size_t)b * 6 * D, m1 + (size_t)b * 6 * D + D, hA + (size_t)t * D, nullptr);
        }
    }
    SEAM(9);

    if (IN(10)) for (int r_ = 0; r_ < REP(10); ++r_) { REPBAR(); LANE_SETUP;
        gemm_stream(lds, L, D, D, 2 * D, (size_t)128 * D * 2, 32 * 16, G, vcu,
            [&](int u) { return (const char*)(hA + (size_t)(u >> 4) * 256 * D); },
            [&](int u) { return (const char*)(Wsgin + (u & 15) * 256); },
            [&](f32x4 (&acc)[2][2][4][2], int u) { const int pm = u >> 4, pn = u & 15;
            const bool isv = pn >= 8; bf16_t* dst = isv ? vbuf : ubuf; const int cb = (pn & 7) * 256;
#pragma unroll
            for (int ai = 0; ai < 2; ++ai)
#pragma unroll
                for (int m = 0; m < 4; ++m) { const int row = pm * 256 + ai * 128 + wr * 64 + m * 16 + fr; float ss = 0.f;
#pragma unroll
                    for (int bj = 0; bj < 2; ++bj)
#pragma unroll
                        for (int n = 0; n < 2; ++n) { const int cl = bj * 128 + wc * 32 + n * 16 + 4 * fq; const f32x4 bi = *(const f32x4*)(sg_b_in + pn * 256 + cl); f32x4 v = acc[ai][bj][m][n] + bi;
                            v[0] = gelu_tanh(v[0]); v[1] = gelu_tanh(v[1]); v[2] = gelu_tanh(v[2]); v[3] = gelu_tanh(v[3]);
                            ss += (v[0] * v[0] + v[1] * v[1]) + (v[2] * v[2] + v[3] * v[3]);
                            u32x2 w; w.x = cvt_pk(v[0], v[1]); w.y = cvt_pk(v[2], v[3]); *(u32x2*)(dst + (size_t)row * D + cb + cl) = w; }
                    if (isv) { ss += __shfl_xor(ss, 16); ss += __shfl_xor(ss, 32); if (fq == 0) vss[(size_t)row * 32 + (pn - 8) * 4 + wc] = ss; } }
            });
    }
    SEAM(10);

    if (IN(11)) for (int r_ = 0; r_ < REP(11); ++r_) { REPBAR(); LANE_SETUP;
        LAS float* rs = (LAS float*)(lds + MISC_OFF + 1024);
        for (int u = vcu; u < 64 * 8; u += G) {
            const int ch = u >> 3, hd = u & 7;
            WAIT_V(0); WAIT_L0(); __syncthreads();
            if (tid < 128) { const f32x4* p = (const f32x4*)(vss + (size_t)(ch * CH + tid) * 32); float s = 0.f;
#pragma unroll
                for (int i = 0; i < 8; ++i) { const f32x4 v = p[i]; s += (v[0] + v[1]) + (v[2] + v[3]); }
                rs[tid] = rsqrtf(s * (1.f / D) + EPS); }
            __syncthreads();
#pragma unroll
            for (int i = 0; i < 4; ++i) { const int idx = tid + i * 512; const int p = idx >> 4, q8 = idx & 15;
                const f32x4 a = *(const f32x4*)(sg_w_s + ((size_t)hd * CH + p) * CH + q8 * 8), b2 = *(const f32x4*)(sg_w_s + ((size_t)hd * CH + p) * CH + q8 * 8 + 4);
                const f32x4 r0 = *(const LAS f32x4*)(rs + q8 * 8), r1 = *(const LAS f32x4*)(rs + q8 * 8 + 4);
                u32x4 w; w.x = cvt_pk(a[0] * r0[0], a[1] * r0[1]); w.y = cvt_pk(a[2] * r0[2], a[3] * r0[3]); w.z = cvt_pk(b2[0] * r1[0], b2[1] * r1[1]); w.w = cvt_pk(b2[2] * r1[2], b2[3] * r1[3]);
                *(LAS u32x4*)(lds + SA_OFF(q8 >> 3, 0) + lds_byte(p, (q8 & 7) * 8)) = w; }
            { const char* Bb = (const char*)(vbuf + (size_t)ch * CH * D + hd * DH);
#pragma unroll
              for (int kt = 0; kt < 2; ++kt)
#pragma unroll
                for (int hh = 0; hh < 2; ++hh)
#pragma unroll
                    for (int i = 0; i < 2; ++i)
                        __builtin_amdgcn_global_load_lds((const unsigned*)(Bb + (size_t)(kt * 64 + L.Rb[i]) * (D * 2) + hh * 256 + L.Cb16[i] * 16), (LAS unsigned*)(lds + SB_OFF(kt, hh) + wid * 1024 + i * 8192), 16, 0, 0); }
            WAIT_V(0); WAIT_L0(); __syncthreads();
            f32x4 ac[2][4][2];
#pragma unroll
            for (int bj = 0; bj < 2; ++bj)
#pragma unroll
                for (int m = 0; m < 4; ++m)
#pragma unroll
                    for (int n = 0; n < 2; ++n) ac[bj][m][n] = (f32x4){0.f, 0.f, 0.f, 0.f};
#pragma unroll
            for (int kt = 0; kt < 2; ++kt) {
                bf16x8 At[4][2];
#pragma unroll
                for (int m = 0; m < 4; ++m)
#pragma unroll
                    for (int k = 0; k < 2; ++k) At[m][k] = *(const LAS bf16x8*)(lds + SA_OFF(kt, 0) + L.aoff + m * 2048 + k * 1024);
#pragma unroll
                for (int bj = 0; bj < 2; ++bj)
#pragma unroll
                    for (int n = 0; n < 2; ++n)
#pragma unroll
                        for (int k = 0; k < 2; ++k) {
                            const s16x4 lo4 = __builtin_amdgcn_ds_read_tr16_b64_v4i16((LAS s16x4*)(lds + SB_OFF(kt, bj) + L.boff[n] + k * 8192));
                            const s16x4 hi4 = __builtin_amdgcn_ds_read_tr16_b64_v4i16((LAS s16x4*)(lds + SB_OFF(kt, bj) + L.boff[n] + k * 8192 + 1024));
                            const bf16x8 bfrag = __builtin_shufflevector(lo4, hi4, 0, 1, 2, 3, 4, 5, 6, 7);
#pragma unroll
                            for (int m = 0; m < 4; ++m) ac[bj][m][n] = __builtin_amdgcn_mfma_f32_16x16x32_bf16(bfrag, At[m][k], ac[bj][m][n], 0, 0, 0);
                        }
            }
#pragma unroll
            for (int m = 0; m < 4; ++m) { const int p = wr * 64 + m * 16 + fr; const size_t tok = (size_t)ch * CH + p; const float bs = sg_b_s[hd * CH + p];
#pragma unroll
                for (int bj = 0; bj < 2; ++bj)
#pragma unroll
                    for (int n = 0; n < 2; ++n) { const int d = hd * DH + bj * 128 + wc * 32 + n * 16 + 4 * fq; const f32x4 gv = *(const f32x4*)(sg_g_v + d); const u32x2 uu = *(const u32x2*)(ubuf + tok * D + d);
                        const f32x4 mx = gv * ac[bj][m][n] + bs;
                        u32x2 w; w.x = cvt_pk(bf_lo(uu.x) * mx[0], bf_hi(uu.x) * mx[1]); w.y = cvt_pk(bf_lo(uu.y) * mx[2], bf_hi(uu.y) * mx[3]); *(u32x2*)(zB + tok * D + d) = w; } }
        }
        WAIT_V(0); WAIT_L0(); __syncthreads();
    }
    SEAM(11);

    if (IN(12)) for (int r_ = 0; r_ < REP(12); ++r_) { REPBAR(); LANE_SETUP;
        gemm_stream(lds, L, D, D, D, (size_t)128 * D * 2, 32 * 8, G, vcu,
            [&](int u) { return (const char*)(zB + (size_t)(u >> 3) * 256 * D); },
            [&](int u) { return (const char*)(Wsgout + (u & 7) * 256); },
            [&](f32x4 (&acc)[2][2][4][2], int u) { const int pm = u >> 3, pn = u & 7;
            RESID_EPI(xb, mod + (size_t)NB * 6 * D + 2 * D, xa);
            });
    }
    SEAM(12);

    if (IN(13)) route_phase(1, xa);
    SEAM(13);
    if (IN(14)) for (int r_ = 0; r_ < REP(14); ++r_) { REPBAR(); moe1_phase(1); }
    SEAM(14);
    if (IN(15)) for (int r_ = 0; r_ < REP(15); ++r_) { REPBAR(); moe2_phase(1); }
    SEAM(15);

    if (IN(16)) for (int r_ = 0; r_ < REP(16); ++r_) { REPBAR(); GET_TID;
        const float* m1 = mod + (size_t)NB * 6 * D;
        for (int t = vcu * 8 + wid; t < T; t += G * 8) {
            const int b = t / S;
            norm_token(lane, xa + (size_t)t * D, ybuf + (size_t)t * 2 * D, ybuf + (size_t)t * 2 * D + D, m1 + (size_t)b * 6 * D + 5 * D, nullptr,
                       g_final, nullptr, nullptr, nullptr, args.out + (size_t)t * D);
        }
    }
#undef IN
#undef SEAM
}
}

extern "C" void kernel_launch(void* const* d_in, const int* in_sizes, int n_in, void* d_out, int out_size, void* d_ws, size_t ws_size, hipStream_t stream) {
    using namespace mk;
    static int grid = 0;
    if (grid == 0) {
        if (n_in != 22 || ws_size < WS_END) { fprintf(stderr, "kernel_launch: unexpected inputs (n_in %d, ws %zu)\n", n_in, ws_size); grid = -1; return; }
        int dev = 0, cus = 0, per_cu = 0;
        hipGetDevice(&dev); hipDeviceGetAttribute(&cus, hipDeviceAttributeMultiprocessorCount, dev);
        if (hipFuncSetAttribute((const void*)mk_fwd, hipFuncAttributeMaxDynamicSharedMemorySize, LDS_BYTES) != hipSuccess) { fprintf(stderr, "kernel_launch: hipFuncSetAttribute failed\n"); grid = -1; return; }
        if (hipOccupancyMaxActiveBlocksPerMultiprocessor(&per_cu, (const void*)mk_fwd, 512, LDS_BYTES) != hipSuccess || per_cu < 1) fprintf(stderr, "kernel_launch: occupancy query says %d\n", per_cu);
        (void)hipGetLastError();
        grid = cus;
    }
    if (grid < 0) return;
    hipMemsetAsync((char*)d_ws + WS_CTL, 0, CTL_BYTES, stream);
    Args a{};
    for (int i = 0; i < 22; ++i) a.in[i] = (const float*)d_in[i];
    a.out = (float*)d_out; a.ws = (unsigned char*)d_ws;
#if MK_MULTI
    for (int p = 0; p < NPH; ++p) { a.ph_lo = p; a.ph_hi = p + 1; hipLaunchKernelGGL(mk_fwd, dim3(grid), dim3(512), LDS_BYTES, stream, a); }
#else
    a.ph_lo = 0; a.ph_hi = NPH;
    hipLaunchKernelGGL(mk_fwd, dim3(grid), dim3(512), LDS_BYTES, stream, a);
#endif
}
```

```cpp
#include <hip/hip_runtime.h>
#include <stdint.h>
#include <cstdio>

#ifndef MK_MULTI
#define MK_MULTI 0
#endif

namespace mk {
#define LAS __attribute__((address_space(3)))
typedef unsigned short bf16_t;
typedef short bf16x8 __attribute__((ext_vector_type(8)));
typedef short s16x4 __attribute__((ext_vector_type(4)));
typedef float f32x4 __attribute__((ext_vector_type(4)));
typedef float f32x2 __attribute__((ext_vector_type(2)));
typedef unsigned u32x2 __attribute__((ext_vector_type(2)));
typedef unsigned u32x4 __attribute__((ext_vector_type(4)));

constexpr int D = 2048, NB = 4, S = 2048, T = NB * S;
constexpr int CG = 512;
constexpr int HEADS = 8, CH = 128, DH = 256;
constexpr int NG = 4, EPG = 8, NE = 32, DE = 512;
constexpr float EPS = 1e-6f;
constexpr int NPH = 17;

constexpr size_t MiB = 1u << 20;
constexpr size_t WS_CTL = 0, CTL_BYTES = 1 * MiB;
constexpr size_t WS_MOD = 1 * MiB;
constexpr size_t WS_WFIN = 2 * MiB;
constexpr size_t WS_WFOUT = 10 * MiB;
constexpr size_t WS_WSGIN = 18 * MiB;
constexpr size_t WS_WSGOUT = 34 * MiB;
constexpr size_t WS_DFTC = 42 * MiB;
constexpr size_t WS_DFTS = 44 * MiB;
constexpr size_t WS_HA = 60 * MiB;
constexpr size_t WS_ZB = 92 * MiB;
constexpr size_t WS_T2 = 124 * MiB;
constexpr size_t WS_FB = 188 * MiB;
constexpr size_t WS_XA = 220 * MiB;
constexpr size_t WS_XB = 284 * MiB;
constexpr size_t WS_ACT = 348 * MiB;
constexpr size_t WS_YB = 366 * MiB;
constexpr size_t WS_VSS = 430 * MiB;
constexpr size_t WS_LISTS = 432 * MiB;
constexpr size_t WS_TOKW = 435 * MiB;
constexpr size_t WS_END = 436 * MiB;
constexpr int CW_COUNTS = 64;
constexpr int CW_BAR = 4096;

constexpr int HTB = 16384;
constexpr int RING_BYTES = 131072;
constexpr int MISC_OFF = RING_BYTES;
constexpr int LDS_BYTES = 147456;
#define SA_OFF(b, h) (((b) * 2 + (h)) * HTB)
#define SB_OFF(b, h) ((4 + (b) * 2 + (h)) * HTB)

#define XB_TMO      128
#define XB_XCNT(j)  (256  + 64 * (j))
#define XB_XSUB(j)  (1280 + 64 * (j))
#define XB_XGEN(j)  (2304 + 64 * (j))
#define XB_TOP      3328
#define XB_TOPGEN   3392
#define XCD_BAR_WORDS 3456
#define XB_SPIN_CAP (1u << 18)
__device__ __forceinline__ unsigned xb_ld(unsigned* p)              { return __hip_atomic_load(p, __ATOMIC_RELAXED, __HIP_MEMORY_SCOPE_AGENT); }
__device__ __forceinline__ unsigned xb_add(unsigned* p, unsigned v) { return __hip_atomic_fetch_add(p, v, __ATOMIC_RELAXED, __HIP_MEMORY_SCOPE_AGENT); }
__device__ __forceinline__ unsigned xb_xcc_id() { return (unsigned)__builtin_amdgcn_s_getreg((3 << 11) | 20) & 0xFu; }
#define XB_SPIN(cond, bar) do { unsigned _sp = 0; while (cond) { __builtin_amdgcn_s_sleep(1); \
    if ((++_sp & 255u) == 0u) { if (xb_ld(&(bar)[XB_TMO])) break; if (_sp > XB_SPIN_CAP) { atomicAdd(&(bar)[XB_TMO], 1u); break; } } } } while (0)
struct XcdBarrier { unsigned* bar; unsigned x; volatile LAS unsigned* st; };
__device__ __forceinline__ XcdBarrier xcd_barrier_post(unsigned* bar, volatile LAS unsigned* st, int tid) {
    XcdBarrier b; b.bar = bar; b.x = xb_xcc_id(); b.st = st;
    if (tid == 0) (void)xb_add(&bar[XB_XCNT(b.x)], 1u);
    return b;
}
__device__ __forceinline__ void xcd_barrier_complete(unsigned* bar, unsigned x, unsigned& nloc, unsigned& nx) {
    const unsigned G = gridDim.x * gridDim.y * gridDim.z;
    unsigned sum, cnt, mine, sp = 0u;
    for (;;) {
        sum = 0u; cnt = 0u; mine = 0u;
#pragma unroll
        for (unsigned j = 0; j < 16; ++j) { const unsigned c = xb_ld(&bar[XB_XCNT(j)]); sum += c; cnt += (c > 0u) ? 1u : 0u; mine = (j == x) ? c : mine; }
        if (sum == G) break;
        __builtin_amdgcn_s_sleep(1);
        if ((++sp & 255u) == 0u) { if (xb_ld(&bar[XB_TMO])) break; if (sp > XB_SPIN_CAP) { atomicAdd(&bar[XB_TMO], 1u); break; } }
    }
    nloc = mine > 0u ? mine : 1u; nx = cnt > 0u ? cnt : 1u;
}
__device__ __forceinline__ void xcd_barrier(const XcdBarrier& b, int tid) {
    asm volatile("s_waitcnt vmcnt(0)" ::: "memory");
    __syncthreads();
    if (tid == 0) {
        unsigned* bar = b.bar;
        __builtin_amdgcn_s_waitcnt(0);
        unsigned nloc = b.st[0], nx = b.st[1];
        if (nloc == 0u) { xcd_barrier_complete(bar, b.x, nloc, nx); b.st[0] = nloc; b.st[1] = nx; }
        const unsigned old = xb_add(&bar[XB_XSUB(b.x)], 1u);
        const unsigned gen = old / nloc;
        if (old + 1u == (gen + 1u) * nloc) {
            __builtin_amdgcn_fence(__ATOMIC_RELEASE, "agent");
            asm volatile("s_waitcnt vmcnt(0)" ::: "memory");
            const unsigned og = xb_add(&bar[XB_TOP], 1u);
            const unsigned tg = og / nx;
            if (og + 1u == (tg + 1u) * nx) xb_add(&bar[XB_TOPGEN], 1u);
            else XB_SPIN(xb_ld(&bar[XB_TOPGEN]) == tg, bar);
            __builtin_amdgcn_fence(__ATOMIC_ACQUIRE, "agent");
            xb_add(&bar[XB_XGEN(b.x)], 1u);
            asm volatile("s_waitcnt vmcnt(0)" ::: "memory");
        } else {
            XB_SPIN(xb_ld(&bar[XB_XGEN(b.x)]) == gen, bar);
            __builtin_amdgcn_fence(__ATOMIC_ACQUIRE, "agent");
            asm volatile("s_waitcnt vmcnt(0)" ::: "memory");
        }
    }
    __syncthreads();
}

__device__ __forceinline__ unsigned cvt_pk(float lo, float hi) { unsigned r; asm("v_cvt_pk_bf16_f32 %0, %1, %2" : "=v"(r) : "v"(lo), "v"(hi)); return r; }
__device__ __forceinline__ float bf_lo(unsigned w) { return __uint_as_float(w << 16); }
__device__ __forceinline__ float bf_hi(unsigned w) { return __uint_as_float(w & 0xffff0000u); }
__device__ __forceinline__ float wave_sum(float v) {
#pragma unroll
    for (int o = 1; o < 64; o <<= 1) v += __shfl_xor(v, o);
    return v;
}
__device__ __forceinline__ int opaque_lane() { int l = (int)__builtin_amdgcn_mbcnt_hi(~0u, __builtin_amdgcn_mbcnt_lo(~0u, 0u)); asm volatile("" : "+v"(l)); return l; }
__device__ __forceinline__ float dpp_add(float v, float w) { return v + w; }
#define DPP_STEP(v, ctrl) v += __builtin_bit_cast(float, __builtin_amdgcn_update_dpp(0, __builtin_bit_cast(int, v), ctrl, 0xf, 0xf, true))
__device__ __forceinline__ float row_sum16(float v) { DPP_STEP(v, 0xB1); DPP_STEP(v, 0x4E); DPP_STEP(v, 0x141); DPP_STEP(v, 0x140); return v; }
#define WAIT_V(n) asm volatile("s_waitcnt vmcnt(" #n ")" ::: "memory")
#define WAIT_L0() asm volatile("s_waitcnt lgkmcnt(0)" ::: "memory")
#define BAR() __builtin_amdgcn_s_barrier()

__device__ __forceinline__ int lds_byte(int r, int c) { const int st = (r >> 4) * 2 + (c >> 5), rr = r & 15, cc = c & 31, ob = rr * 64 + cc * 2; return st * 1024 + (ob ^ (((ob >> 9) & 1) << 5)); }
__device__ __forceinline__ void stage_rc(int b, int& R, int& C) { const int st = b / 1024, sb = b % 1024, swz = sb ^ (((sb >> 9) & 1) << 5); R = (st >> 1) * 16 + swz / 64; C = (st & 1) * 32 + (swz % 64) / 2; }
__device__ __forceinline__ int brow_f(int row) { return (row & 3) | (((row >> 3) & 1) << 2); }

template <int OFF>
__device__ __forceinline__ void ldb_tr(bf16x8 (&dst)[2][2], unsigned a0, unsigned a1) {
    s16x4 r0, r1, r2, r3, r4, r5, r6, r7;
    asm volatile("ds_read_b64_tr_b16 %0, %8 offset:%10\n\t"
                 "ds_read_b64_tr_b16 %1, %8 offset:%11\n\t"
                 "ds_read_b64_tr_b16 %2, %8 offset:%12\n\t"
                 "ds_read_b64_tr_b16 %3, %8 offset:%13\n\t"
                 "ds_read_b64_tr_b16 %4, %9 offset:%10\n\t"
                 "ds_read_b64_tr_b16 %5, %9 offset:%11\n\t"
                 "ds_read_b64_tr_b16 %6, %9 offset:%12\n\t"
                 "ds_read_b64_tr_b16 %7, %9 offset:%13\n\t"
                 "s_waitcnt lgkmcnt(0)"
                 : "=&v"(r0), "=&v"(r1), "=&v"(r2), "=&v"(r3), "=&v"(r4), "=&v"(r5), "=&v"(r6), "=&v"(r7)
                 : "v"(a0), "v"(a1), "n"(OFF), "n"(OFF + 1024), "n"(OFF + 8192), "n"(OFF + 9216) : "memory");
    dst[0][0] = __builtin_shufflevector(r0, r1, 0, 1, 2, 3, 4, 5, 6, 7); dst[0][1] = __builtin_shufflevector(r2, r3, 0, 1, 2, 3, 4, 5, 6, 7);
    dst[1][0] = __builtin_shufflevector(r4, r5, 0, 1, 2, 3, 4, 5, 6, 7); dst[1][1] = __builtin_shufflevector(r6, r7, 0, 1, 2, 3, 4, 5, 6, 7);
}

struct GemmLane {
    int wid, lane, wr, wc, fr, fq;
    int Ra[2], Ca[2];
    unsigned aoff;
    unsigned boff[2];
    int Rb[2], Cb16[2];
};
__device__ __forceinline__ GemmLane make_lane(int tid) {
    GemmLane L;
    L.wid = __builtin_amdgcn_readfirstlane(tid >> 6); L.lane = tid & 63; L.wr = L.wid >> 2; L.wc = L.wid & 3; L.fr = L.lane & 15; L.fq = L.lane >> 4;
#pragma unroll
    for (int i = 0; i < 2; ++i) {
        stage_rc(tid * 16 + i * 8192, L.Ra[i], L.Ca[i]);
        const int row = i * 32 + (tid >> 4); const int slot_phys = (tid & 15) >> 1; const int slot_log = slot_phys ^ brow_f(row);
        L.Rb[i] = row; L.Cb16[i] = slot_log * 2 + (tid & 1);
    }
    L.aoff = (unsigned)lds_byte(L.wr * 64 + L.fr, L.fq * 8);
    const int q = (L.lane & 15) >> 2, p = L.lane & 3, f = q | ((L.fq & 1) << 2);
#pragma unroll
    for (int n = 0; n < 2; ++n) L.boff[n] = (unsigned)((8 * L.fq + q) * 256 + 8 * p + (((L.wc * 2 + n) ^ f) * 32));
    return L;
}

template <int BMODE, int NAI>
__device__ __forceinline__ void gemm_unit(LAS unsigned char* lds, const GemmLane& L, const char* Ab, const unsigned (&voffA)[2][2],
                                          const char* B0, const char* B1, unsigned ldb_bytes, int nt, f32x4 (&acc)[2][2][4][2]) {
    const int wid = L.wid, lane = L.lane;
    asm volatile("" : "+s"(nt));
#pragma unroll
    for (int a = 0; a < 2; ++a)
#pragma unroll
        for (int b = 0; b < 2; ++b)
#pragma unroll
            for (int m = 0; m < 4; ++m)
#pragma unroll
                for (int n = 0; n < 2; ++n) acc[a][b][m][n] = (f32x4){0.f, 0.f, 0.f, 0.f};
    bf16x8 At[4][2], Bf0[2][2], Bf1[2][2];
    const unsigned btr0 = (unsigned)(size_t)lds + SB_OFF(0, 0) + L.boff[0], btr1 = (unsigned)(size_t)lds + SB_OFF(0, 0) + L.boff[1];
    unsigned voffB[2];
    if (BMODE == 0) {
#pragma unroll
        for (int i = 0; i < 2; ++i) voffB[i] = (unsigned)L.Rb[i] * ldb_bytes + (unsigned)L.Cb16[i] * 16u;
    }
    f32x4 X[4], Y[4];
    unsigned bvo = 0, bwf[2] = {0u, 0u};
    if (BMODE == 1) {
        const int hi = lane >> 5;
        bvo = (unsigned)hi * ldb_bytes + (unsigned)(lane & 31) * 16u;
#pragma unroll
        for (int r = 0; r < 2; ++r) bwf[r] = (unsigned)(size_t)lds + SB_OFF(0, 0) + (unsigned)((wid * 8 + hi) * 256 + (lane & 3) * 8 + ((((lane & 31) >> 2) ^ (hi | (r << 1) | ((wid & 1) << 2))) * 32));
    }

#define G_STAGE_A(buf, kt) do { _Pragma("unroll") for (int _h = 0; _h < NAI; ++_h) _Pragma("unroll") for (int _i = 0; _i < 2; ++_i) \
        __builtin_amdgcn_global_load_lds((const unsigned*)(Ab + (size_t)(kt) * 128 + voffA[_h][_i]), (LAS unsigned*)(lds + SA_OFF(buf, _h) + wid * 1024 + _i * 8192), 16, 0, 0); } while (0)
#define G_STAGE_B(buf, kt) do { const char* _bb = B0 + (size_t)(kt) * 64 * ldb_bytes; _Pragma("unroll") for (int _h = 0; _h < 2; ++_h) _Pragma("unroll") for (int _i = 0; _i < 2; ++_i) \
        __builtin_amdgcn_global_load_lds((const unsigned*)(_bb + _h * 256 + voffB[_i]), (LAS unsigned*)(lds + SB_OFF(buf, _h) + wid * 1024 + _i * 8192), 16, 0, 0); } while (0)
#define G_LOADX(V, Bsrc, kt) do { int _lz = lane; asm volatile("" : "+v"(_lz)); const unsigned _bvo = (unsigned)(_lz >> 5) * ldb_bytes + (unsigned)(_lz & 31) * 16u; \
        _Pragma("unroll") for (int _j = 0; _j < 4; ++_j) { const char* _rp = (Bsrc) + (size_t)((kt) * 64 + wid * 8 + 2 * _j) * ldb_bytes; \
            asm volatile("global_load_dwordx4 %0, %1, %2" : "=v"(V[_j]) : "v"(_bvo), "s"(_rp) : "memory"); } } while (0)
#define G_WAITX(V, n) asm volatile("s_waitcnt vmcnt(" #n ")" : "+v"(V[0]), "+v"(V[1]), "+v"(V[2]), "+v"(V[3]) :: "memory")
#define G_WRITEX(V, h, buf) do { int _lz = lane; asm volatile("" : "+v"(_lz)); const int _hi = _lz >> 5; \
        const unsigned _b0 = (unsigned)(size_t)lds + SB_OFF(0, 0) + (unsigned)((wid * 8 + _hi) * 256 + (_lz & 3) * 8); const int _sl = (_lz & 31) >> 2, _fb = _hi | ((wid & 1) << 2); \
        _Pragma("unroll") for (int _j = 0; _j < 4; ++_j) { \
        u32x2 _w; _w.x = cvt_pk(V[_j][0], V[_j][1]); _w.y = cvt_pk(V[_j][2], V[_j][3]); \
        asm volatile("ds_write_b64 %0, %1 offset:%2" :: "v"(_b0 + ((_sl ^ (_fb | ((_j & 1) << 1))) * 32)), "v"(_w), "n"(((buf) * 2 + (h)) * HTB + 2 * _j * 256) : "memory"); } } while (0)
#define G_LDA(buf, h) do { _Pragma("unroll") for (int _m = 0; _m < 4; ++_m) _Pragma("unroll") for (int _k = 0; _k < 2; ++_k) \
        At[_m][_k] = *(const LAS bf16x8*)(lds + SA_OFF(buf, h) + L.aoff + _m * 2048 + _k * 1024); } while (0)
#define G_LDB(dst, buf, h) ldb_tr<((buf) * 2 + (h)) * HTB>(dst, btr0, btr1)
#define G_MMA(ai, bj, Bt) do { _Pragma("unroll") for (int _m = 0; _m < 4; ++_m) _Pragma("unroll") for (int _n = 0; _n < 2; ++_n) _Pragma("unroll") for (int _k = 0; _k < 2; ++_k) \
        acc[ai][bj][_m][_n] = __builtin_amdgcn_mfma_f32_16x16x32_bf16(Bt[_n][_k], At[_m][_k], acc[ai][bj][_m][_n], 0, 0, 0); } while (0)

    WAIT_V(0); WAIT_L0(); BAR();
    if (BMODE == 0) {
        G_STAGE_A(0, 0); G_STAGE_B(0, 0);
#define G_ITER0(p, t) do { WAIT_V(0); BAR(); \
            if ((t) + 1 < nt) { G_STAGE_A(1 - (p), (t) + 1); G_STAGE_B(1 - (p), (t) + 1); } \
            G_LDB(Bf0, p, 0); G_LDA(p, 0); G_MMA(0, 0, Bf0); G_LDB(Bf1, p, 1); G_MMA(0, 1, Bf1); \
            if (NAI == 2) { G_LDA(p, 1); G_MMA(1, 0, Bf0); G_MMA(1, 1, Bf1); } } while (0)
        for (int t = 0; t < nt; t += 2) { G_ITER0(0, t); G_ITER0(1, t + 1); }
#undef G_ITER0
    } else {
        G_LOADX(X, B0, 0); G_LOADX(Y, B1, 0); G_STAGE_A(0, 0);
        G_WAITX(X, 0); G_WAITX(Y, 0);
        G_WRITEX(X, 0, 0); G_WRITEX(Y, 1, 0);
        { const int _k1 = nt > 1 ? 1 : 0; G_LOADX(X, B0, _k1); G_LOADX(Y, B1, _k1); }
#define G_LDA2(buf, h, mh) do { _Pragma("unroll") for (int _m = 0; _m < 2; ++_m) _Pragma("unroll") for (int _k = 0; _k < 2; ++_k) \
        At[_m][_k] = *(const LAS bf16x8*)(lds + SA_OFF(buf, h) + L.aoff + ((mh) * 2 + _m) * 2048 + _k * 1024); } while (0)
#define G_MMA2(ai, bj, mh) do { _Pragma("unroll") for (int _m = 0; _m < 2; ++_m) _Pragma("unroll") for (int _n = 0; _n < 2; ++_n) _Pragma("unroll") for (int _k = 0; _k < 2; ++_k) \
        acc[ai][bj][(mh) * 2 + _m][_n] = __builtin_amdgcn_mfma_f32_16x16x32_bf16(Bf0[_n][_k], At[_m][_k], acc[ai][bj][(mh) * 2 + _m][_n], 0, 0, 0); } while (0)
#define G_BLK(p, ai, bj) do { G_LDA2(p, ai, 0); G_MMA2(ai, bj, 0); G_LDA2(p, ai, 1); G_MMA2(ai, bj, 1); } while (0)
#define G_ITER1(p, t) do { const int _t1 = ((t) + 1 < nt) ? (t) + 1 : nt - 1, _t2 = ((t) + 2 < nt) ? (t) + 2 : nt - 1;     \
            WAIT_V(8); WAIT_L0(); BAR(); \
            G_STAGE_A(1 - (p), _t1); \
            G_LDB(Bf0, p, 0); G_BLK(p, 0, 0); if (NAI == 2) { G_BLK(p, 1, 0); } \
            if (NAI == 2) { G_WAITX(X, 8); } else { G_WAITX(X, 6); } G_WRITEX(X, 0, 1 - (p)); G_LOADX(X, B0, _t2); \
            G_LDB(Bf0, p, 1); G_BLK(p, 0, 1); \
            if (NAI == 2) { G_WAITX(Y, 8); } else { G_WAITX(Y, 6); } G_WRITEX(Y, 1, 1 - (p)); G_LOADX(Y, B1, _t2); \
            if (NAI == 2) { G_BLK(p, 1, 1); } } while (0)
        for (int t = 0; t < nt; t += 2) { G_ITER1(0, t); G_ITER1(1, t + 1); }
        G_WAITX(X, 0); G_WAITX(Y, 0);
#undef G_ITER1
#undef G_BLK
#undef G_MMA2
#undef G_LDA2
    }
#undef G_STAGE_A
#undef G_STAGE_B
#undef G_LOADX
#undef G_WAITX
#undef G_WRITEX
#undef G_LDA
#undef G_LDB
#undef G_MMA
}

template <class AP, class BP, class EP>
__device__ __forceinline__ void gemm_stream(LAS unsigned char* lds, const GemmLane& L, int K, int lda, int ldb, size_t hstepA, int nunits, int G, int vcu, const AP& aptr, const BP& bptr, const EP& epi) {
    const int wid = L.wid, wr = L.wr;
    int nt = K / 64; asm volatile("" : "+s"(nt));
    unsigned voffA[2], voffB[2];
#pragma unroll
    for (int i = 0; i < 2; ++i) { voffA[i] = (unsigned)((L.Ra[i] * lda + L.Ca[i]) * 2); voffB[i] = (unsigned)L.Rb[i] * (unsigned)(ldb * 2) + (unsigned)L.Cb16[i] * 16u; }
    const size_t kstepA = 128, kstepB = (size_t)64 * ldb * 2, hstepB = 256;
    const unsigned ldsw = (unsigned)wid * 1024u;
#define S_STAGE(bufoff, gbase, voff) do { _Pragma("unroll") for (int _i = 0; _i < 2; ++_i) \
        __builtin_amdgcn_global_load_lds((const unsigned*)((const char*)(gbase) + (voff)[_i]), (LAS unsigned*)(lds + (bufoff) + ldsw + _i * 8192), 16, 0, 0); } while (0)
#define S_LDA(dst, b, h) do { _Pragma("unroll") for (int _m = 0; _m < 4; ++_m) _Pragma("unroll") for (int _k = 0; _k < 2; ++_k) \
        dst[_m][_k] = *(const LAS bf16x8*)(lds + SA_OFF(b, h) + L.aoff + _m * 2048 + _k * 1024); } while (0)
#define S_LDB(dst, b, h) ldb_tr<((b) * 2 + (h)) * HTB>(dst, btr0, btr1)
#define S_MMA(ai, bj, Bt) do { __builtin_amdgcn_s_setprio(1); _Pragma("unroll") for (int _m = 0; _m < 4; ++_m) _Pragma("unroll") for (int _n = 0; _n < 2; ++_n) _Pragma("unroll") for (int _k = 0; _k < 2; ++_k) \
        acc[ai][bj][_m][_n] = __builtin_amdgcn_mfma_f32_16x16x32_bf16(Bt[_n][_k], At[_m][_k], acc[ai][bj][_m][_n], 0, 0, 0); __builtin_amdgcn_s_setprio(0); } while (0)
#define S_SCHED __builtin_amdgcn_sched_barrier(0)
#define S_ZERO() do { _Pragma("unroll") for (int _a = 0; _a < 2; ++_a) _Pragma("unroll") for (int _b = 0; _b < 2; ++_b) _Pragma("unroll") for (int _m = 0; _m < 4; ++_m) _Pragma("unroll") for (int _n = 0; _n < 2; ++_n) \
        acc[_a][_b][_m][_n] = (f32x4){0.f, 0.f, 0.f, 0.f}; } while (0)
    int ucur = vcu, ui = 0;
    if (ucur >= nunits) return;
    f32x4 acc[2][2][4][2];
    S_ZERO();
    bf16x8 At[4][2], B0[2][2], B1[2][2];
    const unsigned btr0 = (unsigned)(size_t)lds + SB_OFF(0, 0) + L.boff[0], btr1 = (unsigned)(size_t)lds + SB_OFF(0, 0) + L.boff[1];
    const char* cA = aptr(ucur); const char* cB = bptr(ucur);
    WAIT_V(0); WAIT_L0(); BAR();
    S_STAGE(SB_OFF(0, 0), cB, voffB); S_STAGE(SB_OFF(0, 1), cB + hstepB, voffB); S_STAGE(SA_OFF(0, 0), cA, voffA); S_STAGE(SA_OFF(0, 1), cA + hstepA, voffA);
    if (wr == 1) BAR();
    WAIT_V(2); BAR();
    S_STAGE(SB_OFF(1, 0), cB + kstepB, voffB); S_STAGE(SA_OFF(1, 0), cA + kstepA, voffA); S_STAGE(SB_OFF(1, 1), cB + hstepB + kstepB, voffB);
    WAIT_V(6); BAR();
    for (;;) {
        const int unext = (ui + 1) * G + vcu; const bool has_next = unext < nunits;
        const char* nA = has_next ? aptr(unext) : cA; const char* nB = has_next ? bptr(unext) : cB;
        for (int t = 0; t < nt; t += 2) {
            const bool last = (t == nt - 2);
            const char* a1 = cA + (size_t)(t + 1) * kstepA;
            const char* a2 = last ? nA : cA + (size_t)(t + 2) * kstepA; const char* b2 = last ? nB : cB + (size_t)(t + 2) * kstepB;
            const char* a3 = a2 + kstepA; const char* b3 = b2 + kstepB;
            S_LDB(B0, 0, 0); S_LDB(B1, 0, 1); S_SCHED; S_LDA(At, 0, 0); S_STAGE(SA_OFF(1, 1), a1 + hstepA, voffA);
            WAIT_V(8); WAIT_L0(); BAR(); S_MMA(0, 0, B0); S_MMA(0, 1, B1); BAR(); S_SCHED;
            S_LDA(At, 0, 1); S_STAGE(SB_OFF(0, 0), b2, voffB); S_STAGE(SB_OFF(0, 1), b2 + hstepB, voffB); S_STAGE(SA_OFF(0, 0), a2, voffA);
            WAIT_V(8); WAIT_L0(); BAR(); S_MMA(1, 0, B0); S_MMA(1, 1, B1); BAR(); S_SCHED;
            S_LDB(B0, 1, 0); S_LDB(B1, 1, 1); S_SCHED; S_LDA(At, 1, 0); S_STAGE(SA_OFF(0, 1), a2 + hstepA, voffA);
            WAIT_V(8); WAIT_L0(); BAR(); S_MMA(0, 0, B0); S_MMA(0, 1, B1); BAR(); S_SCHED;
            S_LDA(At, 1, 1); S_STAGE(SB_OFF(1, 0), b3, voffB); S_STAGE(SB_OFF(1, 1), b3 + hstepB, voffB); S_STAGE(SA_OFF(1, 0), a3, voffA);
            WAIT_V(8); WAIT_L0(); BAR(); S_MMA(1, 0, B0); S_MMA(1, 1, B1); BAR(); S_SCHED;
        }
        if (wr == 0) BAR();
        epi(acc, ucur);
        if (!has_next) break;
        S_ZERO();
        ucur = unext; cA = nA; cB = nB; ++ui;
        if (wr == 1) BAR();
    }
    WAIT_V(0);
    BAR();
#undef S_STAGE
#undef S_LDA
#undef S_LDB
#undef S_MMA
#undef S_SCHED
#undef S_ZERO
}

struct Args {
    const float* in[22]; float* out; unsigned char* ws; int ph_lo, ph_hi;
};

__device__ __forceinline__ float gelu_tanh(float v) {
    const float u = 0.7978845608028654f * (v + 0.044715f * v * v * v);
    return v * __builtin_amdgcn_rcpf(1.f + __builtin_amdgcn_exp2f(-2.885390081777927f * u));
}
__device__ __forceinline__ float silu_f(float v) { return v * __builtin_amdgcn_rcpf(1.f + __builtin_amdgcn_exp2f(-1.4426950408889634f * v)); }

__device__ __forceinline__ void norm_token(int lane, const float* xrow, const bf16_t* y0, const bf16_t* y1, const float* gate, float* xout,
                                           const float* g, const float* shift, const float* scale, bf16_t* hout, float* fout) {
    f32x4 v[8]; float ss = 0.f;
#pragma unroll
    for (int j = 0; j < 8; ++j) {
        const int d = 4 * lane + 256 * j;
        f32x4 xv = *(const f32x4*)(xrow + d);
        if (y0) {
            const u32x2 a = *(const u32x2*)(y0 + d), b = *(const u32x2*)(y1 + d); const f32x4 gt = *(const f32x4*)(gate + d);
            xv[0] += gt[0] * (bf_lo(a.x) + bf_lo(b.x)); xv[1] += gt[1] * (bf_hi(a.x) + bf_hi(b.x));
            xv[2] += gt[2] * (bf_lo(a.y) + bf_lo(b.y)); xv[3] += gt[3] * (bf_hi(a.y) + bf_hi(b.y));
            if (xout) *(f32x4*)(xout + d) = xv;
        }
        v[j] = xv; ss += (xv[0] * xv[0] + xv[1] * xv[1]) + (xv[2] * xv[2] + xv[3] * xv[3]);
    }
    const float rstd = rsqrtf(wave_sum(ss) * (1.f / D) + EPS);
#pragma unroll
    for (int j = 0; j < 8; ++j) {
        const int d = 4 * lane + 256 * j;
        const f32x4 gg = *(const f32x4*)(g + d); f32x4 h = v[j] * rstd * gg;
        if (scale) { const f32x4 sc = *(const f32x4*)(scale + d), sh = *(const f32x4*)(shift + d); h = h * (1.f + sc) + sh; }
        if (hout) { u32x2 w; w.x = cvt_pk(h[0], h[1]); w.y = cvt_pk(h[2], h[3]); *(u32x2*)(hout + d) = w; }
        if (fout) *(f32x4*)(fout + d) = h;
    }
}

__global__ void __launch_bounds__(512, 2) mk_fwd(Args args) {
    extern __shared__ __attribute__((aligned(16))) unsigned char lds_raw[];
    LAS unsigned char* lds = (LAS unsigned char*)lds_raw;
    volatile LAS unsigned* MISC = (volatile LAS unsigned*)(lds + MISC_OFF);
    const int wid = __builtin_amdgcn_readfirstlane((int)threadIdx.x >> 6);
#define GET_TID const int lane = opaque_lane(); const int tid = wid * 64 + lane; (void)tid
    const int G = gridDim.x; const int bx = blockIdx.x;
    const int vcu = (G % 8 == 0) ? (bx % 8) * (G / 8) + bx / 8 : bx;
    unsigned char* ws = args.ws;
    unsigned* ctl = (unsigned*)(ws + WS_CTL);
    XcdBarrier bar;
    { GET_TID; if (tid < 4) MISC[tid] = 0u;
      __syncthreads();
      bar = xcd_barrier_post(ctl + CW_BAR, MISC, tid); }
    const int lo = args.ph_lo, hi = args.ph_hi;
#ifndef PH_MASK
#define PH_MASK 0x1FFFF
#endif
#define IN(k) (((PH_MASK >> (k)) & 1) && lo <= (k) && (k) < hi)
#ifndef PROBE_REP
#define PROBE_REP 0
#endif
#define REP(k) ((((PROBE_REP) >> (k)) & 1) ? 2 : 1)
#define REPBAR() do { if (r_ > 0) { const int l2_ = opaque_lane(); xcd_barrier(bar, wid * 64 + l2_); } } while (0)
#define SEAM(k) do { if (IN(k) && IN((k) + 1)) { GET_TID; xcd_barrier(bar, tid); } } while (0)

#define x_in     (args.in[0])
#define c_in     (args.in[1])
#define g_norm1  (args.in[2])
#define g_norm2  (args.in[3])
#define w_ada    (args.in[4])
#define b_ada    (args.in[5])
#define fa_w_in  (args.in[6])
#define fa_w_out (args.in[7])
#define sg_w_in  (args.in[8])
#define sg_b_in  (args.in[9])
#define sg_g_v   (args.in[10])
#define sg_w_s   (args.in[11])
#define sg_b_s   (args.in[12])
#define sg_w_out (args.in[13])
#define w_group  (args.in[14])
#define b_group  (args.in[15])
#define w_router (args.in[16])
#define b_router (args.in[17])
#define w_gate   (args.in[18])
#define w_up     (args.in[19])
#define w_down   (args.in[20])
#define g_final  (args.in[21])
#define mod    ((float*)(args.ws + WS_MOD))
#define Wfin   ((bf16_t*)(args.ws + WS_WFIN))
#define Wfout  ((bf16_t*)(args.ws + WS_WFOUT))
#define Wsgin  ((bf16_t*)(args.ws + WS_WSGIN))
#define Wsgout ((bf16_t*)(args.ws + WS_WSGOUT))
#define DFTC   ((bf16_t*)(args.ws + WS_DFTC))
#define DFTS   ((bf16_t*)(args.ws + WS_DFTS))
#define hA     ((bf16_t*)(args.ws + WS_HA))
#define zB     ((bf16_t*)(args.ws + WS_ZB))
#define T2     ((bf16_t*)(args.ws + WS_T2))
#define fB     ((bf16_t*)(args.ws + WS_FB))
#define ubuf   T2
#define vbuf   (T2 + (size_t)T * D)
#define xa     ((float*)(args.ws + WS_XA))
#define xb     ((float*)(args.ws + WS_XB))
#define act    ((bf16_t*)(args.ws + WS_ACT))
#define ybuf   ((bf16_t*)(args.ws + WS_YB))
#define vss    ((float*)(args.ws + WS_VSS))
#define lists  ((int*)(args.ws + WS_LISTS))
#define tokw   ((float*)(args.ws + WS_TOKW))
#define LANE_SETUP GET_TID; const GemmLane L = make_lane(tid); const int wr = L.wr, wc = L.wc, fr = L.fr, fq = L.fq; f32x4 acc[2][2][4][2]; (void)wr; (void)wc; (void)fr; (void)fq

    if (IN(0)) for (int r_ = 0; r_ < REP(0); ++r_) { REPBAR(); GET_TID;
        {
            LAS float* ca = (LAS float*)lds;
            for (int i = tid; i < NB * D; i += 512) { const float v = c_in[i]; ca[i] = v / (1.f + __expf(-v)); }
            __syncthreads();
            for (int slab = bx; slab < 256; slab += G) {
            const int col0 = slab * 96; const int l = col0 / (6 * D), j0 = col0 % (6 * D);
            const int sub = lane / 24, c4 = lane % 24; const bool act_lane = lane < 48;
            f32x4 a0 = {0, 0, 0, 0}, a1 = a0, a2 = a0, a3 = a0;
            if (act_lane) {
                const float* wp = w_ada + (size_t)l * D * 6 * D + j0 + 4 * c4;
#pragma unroll 8
                for (int it = 0; it < 128; ++it) {
                    const int k = 256 * wid + 2 * it + sub;
                    const f32x4 wv = *(const f32x4*)(wp + (size_t)k * 6 * D);
                    a0 += ca[k] * wv; a1 += ca[D + k] * wv; a2 += ca[2 * D + k] * wv; a3 += ca[3 * D + k] * wv;
                }
            }
            __syncthreads();
            LAS float* red = (LAS float*)(lds + 32768);
            if (act_lane) { LAS f32x4* r = (LAS f32x4*)(red + (wid * 48 + lane) * 16); r[0] = a0; r[1] = a1; r[2] = a2; r[3] = a3; }
            __syncthreads();
            if (tid < 384) {
                const int b = tid / 96, cc = tid % 96, c4i = cc >> 2, e = cc & 3; float s = 0.f;
#pragma unroll
                for (int w = 0; w < 8; ++w)
#pragma unroll
                    for (int sb = 0; sb < 2; ++sb) s += red[(w * 48 + sb * 24 + c4i) * 16 + b * 4 + e];
                mod[((size_t)l * NB + b) * 6 * D + j0 + cc] = s + b_ada[l * 6 * D + j0 + cc];
            }
            __syncthreads();
            }
        }
        {
            const size_t gtid = (size_t)vcu * 512 + tid, gstride = (size_t)G * 512;
            auto conv = [&](const float* src, bf16_t* dst, size_t n8) {
                for (size_t i = gtid; i < n8; i += gstride) { const f32x4 a = *(const f32x4*)(src + i * 8), b = *(const f32x4*)(src + i * 8 + 4);
                    u32x4 w; w.x = cvt_pk(a[0], a[1]); w.y = cvt_pk(a[2], a[3]); w.z = cvt_pk(b[0], b[1]); w.w = cvt_pk(b[2], b[3]); *(u32x4*)(dst + i * 8) = w; } };
            conv(fa_w_in, Wfin, (size_t)D * D / 8); conv(fa_w_out, Wfout, (size_t)D * D / 8);
            conv(sg_w_in, Wsgin, (size_t)D * 2 * D / 8); conv(sg_w_out, Wsgout, (size_t)D * D / 8);
            for (size_t i = gtid; i < (size_t)CG * 1024 / 8; i += gstride) {
                const int n2 = (int)(i / 128), j0 = (int)(i % 128) * 8; float v[8];
#pragma unroll
                for (int e = 0; e < 8; ++e) { const int j = j0 + e, k2 = j & 511; const float ang = (float)((k2 * n2) & 511) * (2.0f / 512.0f); v[e] = (j < 512 ? cospif(ang) : sinpif(ang)) * (1.0f / 32.0f); }
                u32x4 w; w.x = cvt_pk(v[0], v[1]); w.y = cvt_pk(v[2], v[3]); w.z = cvt_pk(v[4], v[5]); w.w = cvt_pk(v[6], v[7]); *(u32x4*)(DFTC + i * 8) = w;
            }
            for (size_t i = gtid; i < (size_t)S * 2048 / 8; i += gstride) {
                const int r = (int)(i / 256), kk0 = (int)(i % 256) * 8; const int k = r & 1023, par = r >> 10; float v[8];
#pragma unroll
                for (int e = 0; e < 8; ++e) { const int kk = kk0 + e, m = kk & 1023, n = 2 * m + par; const float ang = (float)((k * n) & 2047) * (2.0f / 2048.0f); v[e] = (kk < 1024 ? cospif(ang) : -sinpif(ang)) * (1.0f / 32.0f); }
                u32x4 w; w.x = cvt_pk(v[0], v[1]); w.y = cvt_pk(v[2], v[3]); w.z = cvt_pk(v[4], v[5]); w.w = cvt_pk(v[6], v[7]); *(u32x4*)(DFTS + i * 8) = w;
            }
        }
    }
    SEAM(0);

    if (IN(1)) for (int r_ = 0; r_ < REP(1); ++r_) { REPBAR(); GET_TID;
        for (int t = vcu * 8 + wid; t < T; t += G * 8) {
            const int b = t / S; const float* m = mod + (size_t)b * 6 * D;
            norm_token(lane, x_in + (size_t)t * D, nullptr, nullptr, nullptr, nullptr, g_norm1, m, m + D, hA + (size_t)t * D, nullptr);
        }
    }
    SEAM(1);

#define DENSE_UNIT(Aptr, lda, Bptr, ldb, Kdim) do { \
        unsigned _vo[2][2]; _Pragma("unroll") for (int _h = 0; _h < 2; ++_h) _Pragma("unroll") for (int _i = 0; _i < 2; ++_i) _vo[_h][_i] = (unsigned)(((_h * 128 + L.Ra[_i]) * (lda) + L.Ca[_i]) * 2); \
        gemm_unit<0, 2>(lds, L, (const char*)(Aptr), _vo, (const char*)(Bptr), nullptr, (unsigned)((ldb) * 2), (Kdim) / 64, acc); } while (0)

    if (IN(2)) for (int r_ = 0; r_ < REP(2); ++r_) { REPBAR(); LANE_SETUP;
        gemm_stream(lds, L, D, D, D, (size_t)128 * D * 2, 32 * 8, G, vcu,
            [&](int u) { return (const char*)(hA + (size_t)(u >> 3) * 256 * D); },
            [&](int u) { return (const char*)(Wfin + (u & 7) * 256); },
            [&](f32x4 (&acc)[2][2][4][2], int u) { const int pm = u >> 3, pn = u & 7;
#pragma unroll
            for (int ai = 0; ai < 2; ++ai)
#pragma unroll
                for (int m = 0; m < 4; ++m) { const int row = pm * 256 + ai * 128 + wr * 64 + m * 16 + fr;
#pragma unroll
                    for (int bj = 0; bj < 2; ++bj)
#pragma unroll
                        for (int n = 0; n < 2; ++n) { const int col = pn * 256 + bj * 128 + wc * 32 + n * 16 + 4 * fq; const f32x4 v = acc[ai][bj][m][n];
                            u32x2 w; w.x = cvt_pk(v[0], v[1]); w.y = cvt_pk(v[2], v[3]); *(u32x2*)(zB + (size_t)row * D + col) = w; } }
            });
    }
    SEAM(2);

    if (IN(3)) for (int r_ = 0; r_ < REP(3); ++r_) { REPBAR(); LANE_SETUP;
        gemm_stream(lds, L, CG, D, 1024, (size_t)128 * D * 2, 32 * 16, G, vcu,
            [&](int u) { const int pm = u >> 4, g = (u & 15) >> 2; return (const char*)(zB + (size_t)pm * 256 * D + g * CG); },
            [&](int u) { return (const char*)(DFTC + (u & 3) * 256); },
            [&](f32x4 (&acc)[2][2][4][2], int u) { const int pm = u >> 4, pn = u & 15, g = pn >> 2, ct = pn & 3;
            const int which = ct >> 1; const int cbase = g * CG + (ct & 1) * 256;
#pragma unroll
            for (int ai = 0; ai < 2; ++ai)
#pragma unroll
                for (int m = 0; m < 4; ++m) { const int row = pm * 256 + ai * 128 + wr * 64 + m * 16 + fr; const int b = row >> 11, n1 = row & 2047;
                    bf16_t* orow = T2 + ((size_t)(b * 2 + which) * S + n1) * D + cbase;
#pragma unroll
                    for (int bj = 0; bj < 2; ++bj)
#pragma unroll
                        for (int n = 0; n < 2; ++n) { const int col = bj * 128 + wc * 32 + n * 16 + 4 * fq; const f32x4 v = acc[ai][bj][m][n];
                            u32x2 w; w.x = cvt_pk(v[0], v[1]); w.y = cvt_pk(v[2], v[3]); *(u32x2*)(orow + col) = w; } }
            });
    }
    SEAM(3);

    if (IN(4)) for (int r_ = 0; r_ < REP(4); ++r_) { REPBAR(); LANE_SETUP;
        gemm_stream(lds, L, 2048, 2048, 2 * D, (size_t)128 * 2048 * 2, 32 * 8, G, vcu,
            [&](int u) { const int pk = (u >> 3) & 7; return (const char*)(DFTS + (size_t)pk * 256 * 2048); },
            [&](int u) { const int pm = u >> 3, pn = u & 7, b = pm >> 3, par = (pm & 7) >> 2; return (const char*)(T2 + (size_t)b * 2 * S * D + (size_t)par * D + pn * 256); },
            [&](f32x4 (&acc)[2][2][4][2], int u) { const int pm = u >> 3, pn = u & 7;
#pragma unroll
            for (int ai = 0; ai < 2; ++ai)
#pragma unroll
                for (int m = 0; m < 4; ++m) { const int row = pm * 256 + ai * 128 + wr * 64 + m * 16 + fr;
#pragma unroll
                    for (int bj = 0; bj < 2; ++bj)
#pragma unroll
                        for (int n = 0; n < 2; ++n) { const int col = pn * 256 + bj * 128 + wc * 32 + n * 16 + 4 * fq; const f32x4 v = acc[ai][bj][m][n];
                            u32x2 w; w.x = cvt_pk(v[0], v[1]); w.y = cvt_pk(v[2], v[3]); *(u32x2*)(fB + (size_t)row * D + col) = w; } }
            });
    }
    SEAM(4);

#define RESID_EPI(basep, gatep, dstp) do { \
        _Pragma("unroll") for (int ai = 0; ai < 2; ++ai) _Pragma("unroll") for (int m = 0; m < 4; ++m) { const int row = pm * 256 + ai * 128 + wr * 64 + m * 16 + fr; const int b = row >> 11; \
            _Pragma("unroll") for (int bj = 0; bj < 2; ++bj) _Pragma("unroll") for (int n = 0; n < 2; ++n) { const int col = pn * 256 + bj * 128 + wc * 32 + n * 16 + 4 * fq; \
                const f32x4 gt = *(const f32x4*)((gatep) + (size_t)b * 6 * D + col); const f32x4 bs = *(const f32x4*)((basep) + (size_t)row * D + col); \
                *(f32x4*)((dstp) + (size_t)row * D + col) = bs + gt * acc[ai][bj][m][n]; } } } while (0)

    if (IN(5)) for (int r_ = 0; r_ < REP(5); ++r_) { REPBAR(); LANE_SETUP;
        gemm_stream(lds, L, D, D, D, (size_t)1024 * D * 2, 32 * 8, G, vcu,
            [&](int u) { const int pm = u >> 3, b = pm >> 3, kt = pm & 7; return (const char*)(fB + ((size_t)b * S + kt * 128) * D); },
            [&](int u) { return (const char*)(Wfout + (u & 7) * 256); },
            [&](f32x4 (&acc)[2][2][4][2], int u) { const int pm = u >> 3, pn = u & 7, b = pm >> 3, kt = pm & 7;
            const float* gtp = mod + (size_t)b * 6 * D + 2 * D;
#pragma unroll
            for (int m = 0; m < 4; ++m) { const int k = kt * 128 + wr * 64 + m * 16 + fr; const size_t r0 = (size_t)b * S + k, r1 = r0 + 1024;
#pragma unroll
                for (int bj = 0; bj < 2; ++bj)
#pragma unroll
                    for (int n = 0; n < 2; ++n) { const int col = pn * 256 + bj * 128 + wc * 32 + n * 16 + 4 * fq;
                        const f32x4 gt = *(const f32x4*)(gtp + col); const f32x4 ye = acc[0][bj][m][n], yo = acc[1][bj][m][n];
                        const f32x4 x0 = *(const f32x4*)(x_in + r0 * D + col), x1 = *(const f32x4*)(x_in + r1 * D + col);
                        *(f32x4*)(xa + r0 * D + col) = x0 + gt * (ye + yo); *(f32x4*)(xa + r1 * D + col) = x1 + gt * (ye - yo); } }
            });
    }
    SEAM(5);

    auto route_phase = [&](int l, const float* xsrc) { GET_TID;
        const float* g2 = g_norm2 + l * D; const float* m_l = mod + (size_t)l * NB * 6 * D;
        const float* wg = w_group + (size_t)l * D * NG; const float* wrt = w_router + (size_t)l * D * NE;
        const float* bg = b_group + l * NG; const float* brt = b_router + l * NE;
        unsigned* counts = ctl + CW_COUNTS + l * 32; int* lst = lists + (size_t)l * NE * T; float* tw = tokw + (size_t)l * T * 2;
        LAS float* wl = (LAS float*)lds;
        LAS float* lg4 = (LAS float*)(lds + 40960);
        LAS int* sel = (LAS int*)(lds + 40960 + 18432);
        LAS int* rnk = sel + 64;
        LAS int* hist = rnk + 64;
        LAS int* gbase = hist + 32;
#pragma unroll 1
        for (int tb = vcu * 32; tb < T; tb += G * 32) {
            const int b = tb / S; const int tk0 = tb + wid * 4;
            const float* scp = m_l + (size_t)b * 6 * D + 4 * D; const float* shp = m_l + (size_t)b * 6 * D + 3 * D;
            float rstd[4];
#pragma unroll
            for (int k = 0; k < 4; ++k) { const float* xr = xsrc + (size_t)(tk0 + k) * D; float ss = 0.f;
#pragma unroll 8
                for (int i = 0; i < 32; ++i) { const float v = xr[64 * i + lane]; ss += v * v; }
                rstd[k] = rsqrtf(wave_sum(ss) * (1.f / D) + EPS); }
            f32x2 a2[4][18];
#pragma unroll
            for (int k = 0; k < 4; ++k)
#pragma unroll
                for (int o = 0; o < 18; ++o) a2[k][o] = (f32x2){0.f, 0.f};
            if (tid < 32) hist[tid] = 0;
#pragma unroll 1
            for (int j = 0; j < 8; ++j) {
                __syncthreads();
                for (int i = tid; i < 256 * 8; i += 512) { const int ch = i >> 3, c4 = i & 7; const f32x4 v = *(const f32x4*)(wrt + (size_t)(256 * j + ch) * NE + 4 * c4); *(LAS f32x4*)(wl + ch * 36 + 4 + 4 * c4) = v; }
                if (tid < 256) { const f32x4 v = *(const f32x4*)(wg + (size_t)(256 * j + tid) * NG); *(LAS f32x4*)(wl + tid * 36) = v; }
                __syncthreads();
#pragma unroll 1
                for (int cc = 0; cc < 4; ++cc) {
                    const int d = 256 * j + 64 * cc + lane;
                    const float gsc = g2[d] * (1.f + scp[d]), shv = shp[d];
                    f32x2 h2[4];
#pragma unroll
                    for (int k = 0; k < 4; ++k) { const float hh = xsrc[(size_t)(tk0 + k) * D + d] * rstd[k] * gsc + shv; h2[k] = (f32x2){hh, hh};
                        hA[(size_t)(tk0 + k) * D + d] = (bf16_t)(cvt_pk(hh, 0.f) & 0xffffu); }
                    const LAS f32x4* wrow = (const LAS f32x4*)(wl + (cc * 64 + lane) * 36);
#pragma unroll
                    for (int q = 0; q < 9; ++q) { const f32x4 wv = wrow[q]; const f32x2 w01 = (f32x2){wv[0], wv[1]}, w23 = (f32x2){wv[2], wv[3]};
#pragma unroll
                        for (int k = 0; k < 4; ++k) { a2[k][2 * q] += h2[k] * w01; a2[k][2 * q + 1] += h2[k] * w23; } }
                }
            }
#pragma unroll
            for (int k = 0; k < 4; ++k)
#pragma unroll
                for (int o = 0; o < 36; ++o) { const float r = row_sum16(a2[k][o >> 1][o & 1]); if ((lane & 15) == 0) lg4[((wid * 4 + k) * 36 + o) * 4 + (lane >> 4)] = r; }
            __syncthreads();
            if (tid < 32) {
                const LAS f32x4* lp = (const LAS f32x4*)(lg4 + tid * 36 * 4);
                float gl[4];
#pragma unroll
                for (int i = 0; i < 4; ++i) { const f32x4 v = lp[i]; gl[i] = ((v[0] + v[1]) + (v[2] + v[3])) + bg[i]; }
                int gi = 0; float gm = gl[0];
#pragma unroll
                for (int i = 1; i < 4; ++i) if (gl[i] > gm) { gm = gl[i]; gi = i; }
                float se = 0.f;
#pragma unroll
                for (int i = 0; i < 4; ++i) se += __expf(gl[i] - gm);
                const float gw = 1.f / se;
                float el[8];
#pragma unroll
                for (int i = 0; i < 8; ++i) { const f32x4 v = lp[4 + gi * 8 + i]; el[i] = ((v[0] + v[1]) + (v[2] + v[3])) + brt[gi * 8 + i]; }
                int i0 = 0; float v0 = el[0];
#pragma unroll
                for (int i = 1; i < 8; ++i) if (el[i] > v0) { v0 = el[i]; i0 = i; }
                int i1 = 0; float v1 = -3.4e38f;
#pragma unroll
                for (int i = 0; i < 8; ++i) if (i != i0 && el[i] > v1) { v1 = el[i]; i1 = i; }
                const float e1 = __expf(v1 - v0); const float p0 = 1.f / (1.f + e1), p1 = e1 / (1.f + e1);
                const int tk = tb + tid; const int ex0 = gi * EPG + i0, ex1 = gi * EPG + i1;
                tw[tk * 2 + 0] = p0 * gw; tw[tk * 2 + 1] = p1 * gw;
                sel[tid * 2] = ex0; sel[tid * 2 + 1] = ex1;
                rnk[tid * 2] = atomicAdd((int*)&hist[ex0], 1); rnk[tid * 2 + 1] = atomicAdd((int*)&hist[ex1], 1);
            }
            __syncthreads();
            if (tid < 32) { const int c = hist[tid]; gbase[tid] = c > 0 ? (int)atomicAdd(&counts[tid], (unsigned)c) : 0; }
            __syncthreads();
            if (tid < 64) { const int e = sel[tid]; lst[(size_t)e * T + gbase[e] + rnk[tid]] = (tb + (tid >> 1)) * 2 + (tid & 1); }
            __syncthreads();
        }
    };

#define MOE_NUNITS(cnt_, cls_, NCT) ((cls_) == 0 ? ((cnt_) >> 8) * (NCT) : ((cls_) == 1 ? ((((cnt_) & 255) > 128) ? (NCT) : 0) : (((((cnt_) & 255) > 0) && (((cnt_) & 255) <= 128)) ? (NCT) : 0)))
#define MOE_TOTALS(NCT) int tot0 = 0, tot1 = 0, tot2 = 0; \
        _Pragma("unroll 1") for (int i = 0; i < NE; ++i) { const int c_ = (int)counts[i]; tot0 += MOE_NUNITS(c_, 0, NCT); tot1 += MOE_NUNITS(c_, 1, NCT); tot2 += MOE_NUNITS(c_, 2, NCT); } \
        const int tot = tot0 + tot1 + tot2;
#define MOE_FIND(NCT) \
        const int cls = u < tot0 ? 0 : (u < tot0 + tot1 ? 1 : 2); int ur = u - (cls == 0 ? 0 : (cls == 1 ? tot0 : tot0 + tot1)); \
        int e = 0, base = 0, cnt = 0; \
        _Pragma("unroll 1") for (;;) { cnt = (int)counts[e]; const int nun = MOE_NUNITS(cnt, cls, NCT); if (ur < nun || e == NE - 1) break; ur -= nun; base += cnt; ++e; } \
        const int nf = cnt >> 8; const int ct = cls == 0 ? ur / (nf > 0 ? nf : 1) : ur; const int rt = cls == 0 ? ur - ct * nf : nf;
    auto moe1_phase = [&](int l) { LANE_SETUP;
        const unsigned* counts = ctl + CW_COUNTS + l * 32; const int* lst = lists + (size_t)l * NE * T;
        MOE_TOTALS(4)
#pragma unroll 1
        for (int u = vcu; u < tot; u += G) {
            MOE_FIND(4)
            {
                unsigned vo[2][2];
#pragma unroll
                for (int hh = 0; hh < 2; ++hh)
#pragma unroll
                    for (int i = 0; i < 2; ++i) { const int mrow = rt * 256 + hh * 128 + L.Ra[i]; const int ent = (mrow < cnt) ? lst[(size_t)e * T + mrow] : 0; vo[hh][i] = (unsigned)(((ent >> 1) * D + L.Ca[i]) * 2); }
                const float* wgp = w_gate + ((size_t)l * NE + e) * D * DE + ct * 128; const float* wup = w_up + ((size_t)l * NE + e) * D * DE + ct * 128;
                if (cls == 2) gemm_unit<1, 1>(lds, L, (const char*)hA, vo, (const char*)wgp, (const char*)wup, (unsigned)(DE * 4), D / 64, acc);
                else          gemm_unit<1, 2>(lds, L, (const char*)hA, vo, (const char*)wgp, (const char*)wup, (unsigned)(DE * 4), D / 64, acc);
#pragma unroll
                for (int ai = 0; ai < 2; ++ai)
#pragma unroll
                    for (int m = 0; m < 4; ++m) { const int mrow = rt * 256 + ai * 128 + wr * 64 + m * 16 + fr;
                        if (mrow < cnt) { bf16_t* orow = act + (size_t)(base + mrow) * DE + ct * 128;
#pragma unroll
                            for (int n = 0; n < 2; ++n) { const f32x4 gv = acc[ai][0][m][n], uv = acc[ai][1][m][n];
                                u32x2 w; w.x = cvt_pk(silu_f(gv[0]) * uv[0], silu_f(gv[1]) * uv[1]); w.y = cvt_pk(silu_f(gv[2]) * uv[2], silu_f(gv[3]) * uv[3]);
                                *(u32x2*)(orow + wc * 32 + n * 16 + 4 * fq) = w; } }
                        asm volatile("" ::: "memory"); }
            }
        }
    };
    auto moe2_phase = [&](int l) { LANE_SETUP;
        const unsigned* counts = ctl + CW_COUNTS + l * 32; const int* lst = lists + (size_t)l * NE * T; const float* tw = tokw + (size_t)l * T * 2;
        MOE_TOTALS(8)
#pragma unroll 1
        for (int u = vcu; u < tot; u += G) {
            MOE_FIND(8)
            {
                unsigned vo[2][2];
#pragma unroll
                for (int hh = 0; hh < 2; ++hh)
#pragma unroll
                    for (int i = 0; i < 2; ++i) vo[hh][i] = (unsigned)(((hh * 128 + L.Ra[i]) * DE + L.Ca[i]) * 2);
                const float* wdp = w_down + ((size_t)l * NE + e) * DE * D + ct * 256;
                if (cls == 2) gemm_unit<1, 1>(lds, L, (const char*)(act + (size_t)(base + rt * 256) * DE), vo, (const char*)wdp, (const char*)(wdp + 128), (unsigned)(D * 4), DE / 64, acc);
                else          gemm_unit<1, 2>(lds, L, (const char*)(act + (size_t)(base + rt * 256) * DE), vo, (const char*)wdp, (const char*)(wdp + 128), (unsigned)(D * 4), DE / 64, acc);
#pragma unroll
                for (int ai = 0; ai < 2; ++ai)
#pragma unroll
                    for (int m = 0; m < 4; ++m) { const int mrow = rt * 256 + ai * 128 + wr * 64 + m * 16 + fr;
                        if (mrow < cnt) { const int ent = lst[(size_t)e * T + mrow]; const float w8 = tw[ent]; bf16_t* orow = ybuf + (size_t)ent * D + ct * 256;
#pragma unroll
                            for (int bj = 0; bj < 2; ++bj)
#pragma unroll
                                for (int n = 0; n < 2; ++n) { const f32x4 v = acc[ai][bj][m][n] * w8;
                                    u32x2 w; w.x = cvt_pk(v[0], v[1]); w.y = cvt_pk(v[2], v[3]); *(u32x2*)(orow + bj * 128 + wc * 32 + n * 16 + 4 * fq) = w; } }
                        asm volatile("" ::: "memory"); }
            }
        }
    };

    if (IN(6)) route_phase(0, xa);
    SEAM(6);
    if (IN(7)) for (int r_ = 0; r_ < REP(7); ++r_) { REPBAR(); moe1_phase(0); }
    SEAM(7);
    if (IN(8)) for (int r_ = 0; r_ < REP(8); ++r_) { REPBAR(); moe2_phase(0); }
    SEAM(8);

    if (IN(9)) for (int r_ = 0; r_ < REP(9); ++r_) { REPBAR(); GET_TID;
        const float* m1 = mod + (size_t)NB * 6 * D;
        for (int t = vcu * 8 + wid; t < T; t += G * 8) {
            const int b = t / S;
            norm_token(lane, xa + (size_t)t * D, ybuf + (size_t)t * 2 * D, ybuf + (size_t)t * 2 * D + D, mod + (size_t)b * 6 * D + 5 * D, xb + (size_t)t * D,
                       g_norm1 + D, m1 + (size_t)b * 6 * D, m1 + (size_t)b * 6 * D + D, hA + (size_t)t * D, nullptr);
        }
    }
    SEAM(9);

    if (IN(10)) for (int r_ = 0; r_ < REP(10); ++r_) { REPBAR(); LANE_SETUP;
        gemm_stream(lds, L, D, D, 2 * D, (size_t)128 * D * 2, 32 * 16, G, vcu,
            [&](int u) { return (const char*)(hA + (size_t)(u >> 4) * 256 * D); },
            [&](int u) { return (const char*)(Wsgin + (u & 15) * 256); },
            [&](f32x4 (&acc)[2][2][4][2], int u) { const int pm = u >> 4, pn = u & 15;
            const bool isv = pn >= 8; bf16_t* dst = isv ? vbuf : ubuf; const int cb = (pn & 7) * 256;
#pragma unroll
            for (int ai = 0; ai < 2; ++ai)
#pragma unroll
                for (int m = 0; m < 4; ++m) { const int row = pm * 256 + ai * 128 + wr * 64 + m * 16 + fr; float ss = 0.f;
#pragma unroll
                    for (int bj = 0; bj < 2; ++bj)
#pragma unroll
                        for (int n = 0; n < 2; ++n) { const int cl = bj * 128 + wc * 32 + n * 16 + 4 * fq; const f32x4 bi = *(const f32x4*)(sg_b_in + pn * 256 + cl); f32x4 v = acc[ai][bj][m][n] + bi;
                            v[0] = gelu_tanh(v[0]); v[1] = gelu_tanh(v[1]); v[2] = gelu_tanh(v[2]); v[3] = gelu_tanh(v[3]);
                            ss += (v[0] * v[0] + v[1] * v[1]) + (v[2] * v[2] + v[3] * v[3]);
                            u32x2 w; w.x = cvt_pk(v[0], v[1]); w.y = cvt_pk(v[2], v[3]); *(u32x2*)(dst + (size_t)row * D + cb + cl) = w; }
                    if (isv) { ss += __shfl_xor(ss, 16); ss += __shfl_xor(ss, 32); if (fq == 0) vss[(size_t)row * 32 + (pn - 8) * 4 + wc] = ss; } }
            });
    }
    SEAM(10);

    if (IN(11)) for (int r_ = 0; r_ < REP(11); ++r_) { REPBAR(); LANE_SETUP;
        LAS float* rs = (LAS float*)(lds + MISC_OFF + 1024);
        for (int u = vcu; u < 64 * 8; u += G) {
            const int ch = u >> 3, hd = u & 7;
            WAIT_V(0); WAIT_L0(); __syncthreads();
            if (tid < 128) { const f32x4* p = (const f32x4*)(vss + (size_t)(ch * CH + tid) * 32); float s = 0.f;
#pragma unroll
                for (int i = 0; i < 8; ++i) { const f32x4 v = p[i]; s += (v[0] + v[1]) + (v[2] + v[3]); }
                rs[tid] = rsqrtf(s * (1.f / D) + EPS); }
            __syncthreads();
#pragma unroll
            for (int i = 0; i < 4; ++i) { const int idx = tid + i * 512; const int p = idx >> 4, q8 = idx & 15;
                const f32x4 a = *(const f32x4*)(sg_w_s + ((size_t)hd * CH + p) * CH + q8 * 8), b2 = *(const f32x4*)(sg_w_s + ((size_t)hd * CH + p) * CH + q8 * 8 + 4);
                const f32x4 r0 = *(const LAS f32x4*)(rs + q8 * 8), r1 = *(const LAS f32x4*)(rs + q8 * 8 + 4);
                u32x4 w; w.x = cvt_pk(a[0] * r0[0], a[1] * r0[1]); w.y = cvt_pk(a[2] * r0[2], a[3] * r0[3]); w.z = cvt_pk(b2[0] * r1[0], b2[1] * r1[1]); w.w = cvt_pk(b2[2] * r1[2], b2[3] * r1[3]);
                *(LAS u32x4*)(lds + SA_OFF(q8 >> 3, 0) + lds_byte(p, (q8 & 7) * 8)) = w; }
            { const char* Bb = (const char*)(vbuf + (size_t)ch * CH * D + hd * DH);
#pragma unroll
              for (int kt = 0; kt < 2; ++kt)
#pragma unroll
                for (int hh = 0; hh < 2; ++hh)
#pragma unroll
                    for (int i = 0; i < 2; ++i)
                        __builtin_amdgcn_global_load_lds((const unsigned*)(Bb + (size_t)(kt * 64 + L.Rb[i]) * (D * 2) + hh * 256 + L.Cb16[i] * 16), (LAS unsigned*)(lds + SB_OFF(kt, hh) + wid * 1024 + i * 8192), 16, 0, 0); }
            WAIT_V(0); WAIT_L0(); __syncthreads();
            f32x4 ac[2][4][2];
#pragma unroll
            for (int bj = 0; bj < 2; ++bj)
#pragma unroll
                for (int m = 0; m < 4; ++m)
#pragma unroll
                    for (int n = 0; n < 2; ++n) ac[bj][m][n] = (f32x4){0.f, 0.f, 0.f, 0.f};
#pragma unroll
            for (int kt = 0; kt < 2; ++kt) {
                bf16x8 At[4][2];
#pragma unroll
                for (int m = 0; m < 4; ++m)
#pragma unroll
                    for (int k = 0; k < 2; ++k) At[m][k] = *(const LAS bf16x8*)(lds + SA_OFF(kt, 0) + L.aoff + m * 2048 + k * 1024);
#pragma unroll
                for (int bj = 0; bj < 2; ++bj)
#pragma unroll
                    for (int n = 0; n < 2; ++n)
#pragma unroll
                        for (int k = 0; k < 2; ++k) {
                            const s16x4 lo4 = __builtin_amdgcn_ds_read_tr16_b64_v4i16((LAS s16x4*)(lds + SB_OFF(kt, bj) + L.boff[n] + k * 8192));
                            const s16x4 hi4 = __builtin_amdgcn_ds_read_tr16_b64_v4i16((LAS s16x4*)(lds + SB_OFF(kt, bj) + L.boff[n] + k * 8192 + 1024));
                            const bf16x8 bfrag = __builtin_shufflevector(lo4, hi4, 0, 1, 2, 3, 4, 5, 6, 7);
#pragma unroll
                            for (int m = 0; m < 4; ++m) ac[bj][m][n] = __builtin_amdgcn_mfma_f32_16x16x32_bf16(bfrag, At[m][k], ac[bj][m][n], 0, 0, 0);
                        }
            }
#pragma unroll
            for (int m = 0; m < 4; ++m) { const int p = wr * 64 + m * 16 + fr; const size_t tok = (size_t)ch * CH + p; const float bs = sg_b_s[hd * CH + p];
#pragma unroll
                for (int bj = 0; bj < 2; ++bj)
#pragma unroll
                    for (int n = 0; n < 2; ++n) { const int d = hd * DH + bj * 128 + wc * 32 + n * 16 + 4 * fq; const f32x4 gv = *(const f32x4*)(sg_g_v + d); const u32x2 uu = *(const u32x2*)(ubuf + tok * D + d);
                        const f32x4 mx = gv * ac[bj][m][n] + bs;
                        u32x2 w; w.x = cvt_pk(bf_lo(uu.x) * mx[0], bf_hi(uu.x) * mx[1]); w.y = cvt_pk(bf_lo(uu.y) * mx[2], bf_hi(uu.y) * mx[3]); *(u32x2*)(zB + tok * D + d) = w; } }
        }
        WAIT_V(0); WAIT_L0(); __syncthreads();
    }
    SEAM(11);

    if (IN(12)) for (int r_ = 0; r_ < REP(12); ++r_) { REPBAR(); LANE_SETUP;
        gemm_stream(lds, L, D, D, D, (size_t)128 * D * 2, 32 * 8, G, vcu,
            [&](int u) { return (const char*)(zB + (size_t)(u >> 3) * 256 * D); },
            [&](int u) { return (const char*)(Wsgout + (u & 7) * 256); },
            [&](f32x4 (&acc)[2][2][4][2], int u) { const int pm = u >> 3, pn = u & 7;
            RESID_EPI(xb, mod + (size_t)NB * 6 * D + 2 * D, xa);
            });
    }
    SEAM(12);

    if (IN(13)) route_phase(1, xa);
    SEAM(13);
    if (IN(14)) for (int r_ = 0; r_ < REP(14); ++r_) { REPBAR(); moe1_phase(1); }
    SEAM(14);
    if (IN(15)) for (int r_ = 0; r_ < REP(15); ++r_) { REPBAR(); moe2_phase(1); }
    SEAM(15);

    if (IN(16)) for (int r_ = 0; r_ < REP(16); ++r_) { REPBAR(); GET_TID;
        const float* m1 = mod + (size_t)NB * 6 * D;
        for (int t = vcu * 8 + wid; t < T; t += G * 8) {
            const int b = t / S;
            norm_token(lane, xa + (size_t)t * D, ybuf + (size_t)t * 2 * D, ybuf + (size_t)t * 2 * D + D, m1 + (size_t)b * 6 * D + 5 * D, nullptr,
                       g_final, nullptr, nullptr, nullptr, args.out + (size_t)t * D);
        }
    }
#undef IN
#undef SEAM
}
}

extern "C" void kernel_launch(void* const* d_in, const int* in_sizes, int n_in, void* d_out, int out_size, void* d_ws, size_t ws_size, hipStream_t stream) {
    using namespace mk;
    static int grid = 0;
    if (grid == 0) {
        if (n_in != 22 || ws_size < WS_END) { fprintf(stderr, "kernel_launch: unexpected inputs (n_in %d, ws %zu)\n", n_in, ws_size); grid = -1; return; }
        int dev = 0, cus = 0, per_cu = 0;
        hipGetDevice(&dev); hipDeviceGetAttribute(&cus, hipDeviceAttributeMultiprocessorCount, dev);
        if (hipFuncSetAttribute((const void*)mk_fwd, hipFuncAttributeMaxDynamicSharedMemorySize, LDS_BYTES) != hipSuccess) { fprintf(stderr, "kernel_launch: hipFuncSetAttribute failed\n"); grid = -1; return; }
        if (hipOccupancyMaxActiveBlocksPerMultiprocessor(&per_cu, (const void*)mk_fwd, 512, LDS_BYTES) != hipSuccess || per_cu < 1) fprintf(stderr, "kernel_launch: occupancy query says %d\n", per_cu);
        (void)hipGetLastError();
        grid = cus;
    }
    if (grid < 0) return;
    hipMemsetAsync((char*)d_ws + WS_CTL, 0, CTL_BYTES, stream);
    Args a{};
    for (int i = 0; i < 22; ++i) a.in[i] = (const float*)d_in[i];
    a.out = (float*)d_out; a.ws = (unsigned char*)d_ws;
#if MK_MULTI
    for (int p = 0; p < NPH; ++p) { a.ph_lo = p; a.ph_hi = p + 1; hipLaunchKernelGGL(mk_fwd, dim3(grid), dim3(512), LDS_BYTES, stream, a); }
#else
    a.ph_lo = 0; a.ph_hi = NPH;
    hipLaunchKernelGGL(mk_fwd, dim3(grid), dim3(512), LDS_BYTES, stream, a);
#endif
}
```
